# Optimizing an MI355X kernel written in HIP

```python
import math
import jax
import jax.numpy as jnp
from jax import lax
import numpy as np

D_MODEL = 1024
BATCH = 4
SEQ = 8192
DEPTH = 1

CTX_LEN = 256
GRID_W = 64
CHUNK = 128
ROWS_PER_CHUNK = CHUNK // GRID_W
MIX_W = D_MODEL
S5_W = D_MODEL // 4
GM_W = MIX_W - S5_W
GM_HEAD_DIM = 128
GM_HEADS = GM_W // GM_HEAD_DIM
S5_GROUP = 16
S5_GROUPS = S5_W // S5_GROUP
S5_STATE = 64
IN_COLS = S5_W + 2 * GM_W
N_EXPERTS = 16
CAPACITY_FACTOR = 2
D_FF = 2816
ALPHA = (2.0 * DEPTH) ** 0.25
BETA = (8.0 * DEPTH) ** -0.25
LN_EPS = 1e-6

kernel_name = 'hybrid_gmlp_s5_ecmoe_prefix_dit_block'


def layer_norm(x, g=None, b=None):
    xf = x.astype(jnp.float32)
    mu = jnp.mean(xf, axis=-1, keepdims=True)
    var = jnp.mean(jnp.square(xf - mu), axis=-1, keepdims=True)
    y = (xf - mu) * lax.rsqrt(var + LN_EPS)
    if g is not None:
        y = y * g.astype(jnp.float32) + b.astype(jnp.float32)
    return y.astype(x.dtype)


def modulate(x, shift, scale):
    return layer_norm(x) * (1 + scale) + shift


def chunk_mlp(u, v, w_s, b_s, n_chunks):
    bn, length, _ = u.shape
    u = u.reshape(bn, n_chunks, CHUNK, GM_HEADS, GM_HEAD_DIM)
    v = layer_norm(v.reshape(bn, n_chunks, CHUNK, GM_HEADS, GM_HEAD_DIM))
    mixed = jnp.einsum('gqk,bnkgc->bnqgc', w_s, v) + jnp.swapaxes(b_s, 0, 1)[:, :, None]
    return (u * mixed).reshape(bn, length, GM_W)


def diag_scan(lam_bar, drive, s0=None):
    length = drive.shape[1]
    a = jnp.broadcast_to(lam_bar, (1, length) + lam_bar.shape)

    def combine(e1, e2):
        a1, b1 = e1
        a2, b2 = e2
        return a1 * a2, a2 * b1 + b2

    a_cum, s = lax.associative_scan(combine, (a, drive), axis=1)
    if s0 is not None:
        s = s + a_cum * s0[:, None]
    return s


def s5_direction(u_lat, u_ctx, a_re, a_im, log_step, b_re, b_im, c_re, c_im, need_ctx):
    f32 = jnp.float32
    lam = lax.complex(a_re.astype(f32), a_im.astype(f32))
    lam_bar = jnp.exp(lam * jnp.exp(log_step.astype(f32))[:, None])
    b_bar = ((lam_bar - 1.0) / lam)[:, :, None] * lax.complex(b_re.astype(f32), b_im.astype(f32))
    c_mat = lax.complex(c_re.astype(f32), c_im.astype(f32))

    def drive(u):
        return jnp.einsum('blgh,gph->blgp', u.astype(f32).astype(jnp.complex64), b_bar)

    def readout(s):
        return jnp.real(jnp.einsum('blgp,ghp->blgh', s, c_mat))

    s_ctx = diag_scan(lam_bar, drive(u_ctx))
    s_lat = diag_scan(lam_bar, drive(u_lat), s_ctx[:, -1])
    y_ctx = readout(s_ctx) if need_ctx else None
    return readout(s_lat), y_ctx


def s5_block(u_lat, u_ctx, a_re, a_im, log_step, b_re, b_im, c_re, c_im, d, w_glu, b_glu, need_ctx):
    dtype = u_lat.dtype

    def groups(u):
        return u.reshape(u.shape[0], u.shape[1], S5_GROUPS, S5_GROUP)

    def flip(t, rev):
        return jnp.flip(t, axis=1) if rev else t

    def glu(y):
        g = jax.nn.gelu(y.reshape(y.shape[0], y.shape[1], S5_W).astype(dtype))
        return g * jax.nn.sigmoid(g @ w_glu + b_glu)

    ug, ucg = groups(u_lat), groups(u_ctx)
    d32 = d.astype(jnp.float32)
    y = d32 * ug.astype(jnp.float32)
    yc = d32 * ucg.astype(jnp.float32) if need_ctx else None
    for direction in range(2):
        rev = direction == 1
        yd, ycd = s5_direction(flip(ug, rev), flip(ucg, rev), a_re[direction], a_im[direction],
                               log_step[direction], b_re[direction], b_im[direction],
                               c_re[direction], c_im[direction], need_ctx)
        y = y + flip(yd, rev)
        if need_ctx:
            yc = yc + flip(ycd, rev)
    out_ctx = glu(yc) if need_ctx else None
    return glu(y), out_ctx


def ec_moe(h, w_router, w_gate, w_up, w_down):
    bn, length, _ = h.shape
    cap = CAPACITY_FACTOR * length // N_EXPERTS
    aff = jax.nn.softmax((h @ w_router).astype(jnp.float32), axis=-1)
    gate, idx = lax.top_k(jnp.swapaxes(aff, 1, 2), cap)
    bidx = jnp.arange(bn)[:, None, None]
    xg = h[bidx, idx]
    hid = jax.nn.silu(jnp.einsum('becd,edf->becf', xg, w_gate)) * jnp.einsum('becd,edf->becf', xg, w_up)
    out = jnp.einsum('becf,efd->becd', hid, w_down) * gate[..., None].astype(h.dtype)
    return jnp.zeros_like(h).at[bidx, idx].add(out)


def hybrid_layer(x, xc, mod_lat, mod_ctx, n_chunks_lat, w_in, gm_ws, gm_bs, s5_a_re, s5_a_im, s5_log_step,
                 s5_b_re, s5_b_im, s5_c_re, s5_c_im, s5_d, s5_w_glu, s5_b_glu, w_out, ln1_g, ln1_b,
                 w_router, moe_w_gate, moe_w_up, moe_w_down, ln2_g, ln2_b, update_ctx):
    sh1, sc1, g1, sh2, sc2, g2 = jnp.split(mod_lat, 6, axis=-1)
    csh1, csc1, cg1, csh2, csc2, cg2 = jnp.split(mod_ctx, 6, axis=-1)
    z = modulate(x, sh1, sc1) @ w_in
    zc = modulate(xc, csh1, csc1) @ (w_in if update_ctx else w_in[:, :S5_W])
    s5_lat, s5_ctx = s5_block(z[..., :S5_W], zc[..., :S5_W], s5_a_re, s5_a_im, s5_log_step, s5_b_re, s5_b_im,
                              s5_c_re, s5_c_im, s5_d, s5_w_glu, s5_b_glu, update_ctx)
    gm_lat = chunk_mlp(jax.nn.gelu(z[..., S5_W:S5_W + GM_W]), jax.nn.gelu(z[..., S5_W + GM_W:]),
                       gm_ws, gm_bs, n_chunks_lat)
    mix = jnp.concatenate([s5_lat, gm_lat], axis=-1) @ w_out
    x_new = layer_norm(ALPHA * x + g1 * mix, ln1_g, ln1_b)
    moe = ec_moe(modulate(x_new, sh2, sc2), w_router, moe_w_gate, moe_w_up, moe_w_down)
    x_new = layer_norm(ALPHA * x_new + g2 * moe, ln2_g, ln2_b)
    if update_ctx:
        gm_ctx = chunk_mlp(jax.nn.gelu(zc[..., S5_W:S5_W + GM_W]), jax.nn.gelu(zc[..., S5_W + GM_W:]),
                           gm_ws, gm_bs, xc.shape[1] // CHUNK)
        mix_c = jnp.concatenate([s5_ctx, gm_ctx], axis=-1) @ w_out
        xc = layer_norm(ALPHA * xc + cg1 * mix_c, ln1_g, ln1_b)
        moe_c = ec_moe(modulate(xc, csh2, csc2), w_router, moe_w_gate, moe_w_up, moe_w_down)
        xc = layer_norm(ALPHA * xc + cg2 * moe_c, ln2_g, ln2_b)
    return x_new, xc


def setup_inputs(seed: int = 0) -> dict:
    key = jax.random.key(seed)
    ks = jax.random.split(key, 32)
    f32 = jnp.float32

    def nrm(k, shape, scale=1.0):
        return jax.random.normal(k, shape, f32) * scale

    L2 = (DEPTH, 2, S5_GROUPS)
    return {
        'x': nrm(ks[0], (BATCH, SEQ, D_MODEL)),
        'c': nrm(ks[1], (BATCH, D_MODEL)),
        'ctx': nrm(ks[2], (BATCH, CTX_LEN, D_MODEL)),
        'c_ctx': nrm(ks[3], (D_MODEL,)),
        'w_ada': nrm(ks[4], (DEPTH, D_MODEL, 6 * D_MODEL), D_MODEL ** -0.5),
        'b_ada': nrm(ks[5], (DEPTH, 6 * D_MODEL), 0.02),
        'w_in': nrm(ks[6], (DEPTH, D_MODEL, IN_COLS), D_MODEL ** -0.5),
        'gm_ws': nrm(ks[7], (DEPTH, GM_HEADS, CHUNK, CHUNK), CHUNK ** -0.5),
        'gm_bs': 1.0 + nrm(ks[8], (DEPTH, GM_HEADS, CHUNK), 0.02),
        's5_a_re': -0.5 + nrm(ks[9], L2 + (S5_STATE,), 0.01),
        's5_a_im': math.pi * jnp.arange(S5_STATE, dtype=f32) + nrm(ks[10], L2 + (S5_STATE,), 0.01),
        's5_log_step': jax.random.uniform(ks[11], L2, f32, math.log(1e-3), math.log(1e-1)),
        's5_b_re': nrm(ks[12], L2 + (S5_STATE, S5_GROUP), (2.0 * S5_GROUP) ** -0.5),
        's5_b_im': nrm(ks[13], L2 + (S5_STATE, S5_GROUP), (2.0 * S5_GROUP) ** -0.5),
        's5_c_re': nrm(ks[14], L2 + (S5_GROUP, S5_STATE), (2.0 * S5_STATE) ** -0.5),
        's5_c_im': nrm(ks[15], L2 + (S5_GROUP, S5_STATE), (2.0 * S5_STATE) ** -0.5),
        's5_d': nrm(ks[16], (DEPTH, S5_GROUPS, S5_GROUP)),
        's5_w_glu': nrm(ks[17], (DEPTH, S5_W, S5_W), S5_W ** -0.5),
        's5_b_glu': nrm(ks[18], (DEPTH, S5_W), 0.02),
        'w_out': nrm(ks[19], (DEPTH, MIX_W, D_MODEL), BETA * MIX_W ** -0.5),
        'ln1_g': 1.0 + nrm(ks[20], (DEPTH, D_MODEL), 0.02),
        'ln1_b': nrm(ks[21], (DEPTH, D_MODEL), 0.02),
        'w_router': nrm(ks[22], (DEPTH, D_MODEL, N_EXPERTS), D_MODEL ** -0.5),
        'moe_w_gate': nrm(ks[23], (DEPTH, N_EXPERTS, D_MODEL, D_FF), D_MODEL ** -0.5),
        'moe_w_up': nrm(ks[24], (DEPTH, N_EXPERTS, D_MODEL, D_FF), D_MODEL ** -0.5),
        'moe_w_down': nrm(ks[25], (DEPTH, N_EXPERTS, D_FF, D_MODEL), BETA * D_FF ** -0.5),
        'ln2_g': 1.0 + nrm(ks[26], (DEPTH, D_MODEL), 0.02),
        'ln2_b': nrm(ks[27], (DEPTH, D_MODEL), 0.02),
    }


def reference(x, c, ctx, c_ctx, w_ada, b_ada, w_in, gm_ws, gm_bs, s5_a_re, s5_a_im, s5_log_step,
              s5_b_re, s5_b_im, s5_c_re, s5_c_im, s5_d, s5_w_glu, s5_b_glu, w_out, ln1_g, ln1_b,
              w_router, moe_w_gate, moe_w_up, moe_w_down, ln2_g, ln2_b):
    rows = x.shape[1] // GRID_W
    n_chunks_lat = rows // ROWS_PER_CHUNK
    xc = ctx
    for l in range(DEPTH):
        mod_lat = (jax.nn.silu(c) @ w_ada[l] + b_ada[l])[:, None, :]
        mod_ctx = (jax.nn.silu(c_ctx) @ w_ada[l] + b_ada[l])[None, None, :]
        x, xc = hybrid_layer(x, xc, mod_lat, mod_ctx, n_chunks_lat, w_in[l], gm_ws[l], gm_bs[l],
                             s5_a_re[l], s5_a_im[l], s5_log_step[l], s5_b_re[l], s5_b_im[l],
                             s5_c_re[l], s5_c_im[l], s5_d[l], s5_w_glu[l], s5_b_glu[l], w_out[l],
                             ln1_g[l], ln1_b[l], w_router[l], moe_w_gate[l], moe_w_up[l],
                             moe_w_down[l], ln2_g[l], ln2_b[l], l < DEPTH - 1)
    return x
```

```cpp
#include <hip/hip_runtime.h>
#include <cstdio>
#include <cstdint>

#ifndef MK_N_LAUNCHES
#define MK_N_LAUNCHES 1
#endif

namespace pg8 {
#define PG8_LAS __attribute__((address_space(3)))
typedef unsigned short bf16_t;
typedef short bf16x8 __attribute__((ext_vector_type(8)));
typedef float f32x4 __attribute__((ext_vector_type(4)));
typedef float f32x2 __attribute__((ext_vector_type(2)));
typedef unsigned u32x4 __attribute__((ext_vector_type(4)));
typedef unsigned u32x2 __attribute__((ext_vector_type(2)));
constexpr int BM = 256, BK = 64, HALF = 128, HTB = HALF * BK * 2  , STAGE_BYTES = 8 * HTB, NXCD = 8, WGM = 8;

__host__ __device__ __forceinline__ int lds_byte(int r, int c) { const int st = (r >> 4) * 2 + (c >> 5), rr = r & 15, cc = c & 31, ob = rr * 64 + cc * 2; return st * 1024 + (ob ^ (((ob >> 9) & 1) << 5)); }
__host__ __device__ __forceinline__ void stage_rc(int b, int& R, int& C) { const int st = b / 1024, sb = b % 1024, swz = sb ^ (((sb >> 9) & 1) << 5); R = (st >> 1) * 16 + swz / 64; C = (st & 1) * 32 + (swz % 64) / 2; }
__host__ __device__ __forceinline__ int perm32(int rho) { const int n = rho >> 4, i = rho & 15; return 8 * (i >> 2) + 4 * n + (i & 3); }

struct Unit { int pm, pn, z; };

__device__ __forceinline__ void tile_order(int L, int nM, int nN, int& pm, int& pn) {
    const int nwg = nM * nN; int wgid = L;
    { const int q = nwg / NXCD, r = nwg % NXCD, xcd = wgid % NXCD, off = wgid / NXCD; wgid = (xcd < r ? xcd * (q + 1) : r * (q + 1) + (xcd - r) * q) + off; }
    const int nig = WGM * nN, gid = wgid / nig, fm = gid * WGM, gsz = (nM - fm) < WGM ? (nM - fm) : WGM;
    pm = fm + ((wgid % nig) % gsz); pn = (wgid % nig) / gsz;
}

__device__ __forceinline__ unsigned cvt_pk_bf16(float lo, float hi) { unsigned r; asm volatile("v_cvt_pk_bf16_f32 %0, %1, %2" : "=v"(r) : "v"(lo), "v"(hi)); return r; }
__device__ __forceinline__ float bf_lo(unsigned w) { return __uint_as_float(w << 16); }
__device__ __forceinline__ float bf_hi(unsigned w) { return __uint_as_float(w & 0xffff0000u); }
__device__ __forceinline__ float fast_sigmoid(float x) { return __builtin_amdgcn_rcpf(1.0f + __builtin_amdgcn_exp2f(-1.44269504f * x)); }
__device__ __forceinline__ float gelu_tanh(float x) { const float u = x * (1.0f + 0.044715f * x * x) * 1.5957691216f; return x * fast_sigmoid(u); }

template <class P>
__device__ __forceinline__ void gemm_phase(PG8_LAS unsigned char* lds, const P& p) {
    const int tid = threadIdx.x, wid = __builtin_amdgcn_readfirstlane(tid >> 6), lane = tid & 63, wr = wid >> 2, wc = wid & 3, fr = lane & 15, fq = lane >> 4;
    constexpr int K = P::K, nt = K / BK, lda = P::LDA, ldb = P::LDB;
    static_assert(K % 128 == 0 && K >= 256, "K multiple of 128, >= 256");
    int Rr[2], Cc[2]; unsigned voB[2];
#pragma unroll
    for (int i = 0; i < 2; ++i) { int R, C; stage_rc(tid * 16 + i * 8192, R, C); Rr[i] = R; Cc[i] = C; const int Rb = P::PERM ? ((R & ~31) + perm32(R & 31)) : R; voB[i] = (unsigned)(Rb * ldb + C) * 2u; }
    unsigned voA[2][2], nvoA[2][2];
#define PG8_SETVOA(v, u) do { _Pragma("unroll") for (int _h = 0; _h < 2; ++_h) _Pragma("unroll") for (int _i = 0; _i < 2; ++_i) { const int _r = _h * HALF + Rr[_i]; \
        unsigned _row; if constexpr (P::GATHER) _row = (unsigned)p.a_row(u, _r); else _row = (unsigned)_r; v[_h][_i] = (_row * (unsigned)lda + (unsigned)Cc[_i]) * 2u; } } while (0)
    const size_t kstep = (size_t)(BK * 2);
    const size_t hstepB = (size_t)HALF * ldb * 2;
    const unsigned ldsw = (unsigned)wid * 1024u;
    const int aoff = lds_byte(wr * 64 + fr, fq * 8), boff = lds_byte(wc * 32 + fr, fq * 8);
#define PG8_SA(b, h) (((b) * 2 + (h)) * HTB)
#define PG8_SB(b, h) ((4 + (b) * 2 + (h)) * HTB)
#define PG8_STAGE(bufoff, gbase, v0, v1) do { \
        __builtin_amdgcn_global_load_lds((const unsigned*)((const char*)(gbase) + (v0)), (PG8_LAS unsigned*)(lds + (bufoff) + ldsw), 16, 0, 0); \
        __builtin_amdgcn_global_load_lds((const unsigned*)((const char*)(gbase) + (v1)), (PG8_LAS unsigned*)(lds + (bufoff) + ldsw + 8192), 16, 0, 0); } while (0)
#define PG8_STAGE_A(bufoff, gbase, V, h) PG8_STAGE(bufoff, gbase, V[h][0], V[h][1])
#define PG8_STAGE_B(bufoff, gbase) PG8_STAGE(bufoff, gbase, voB[0], voB[1])
#define PG8_LDA(dst, b, h) do { _Pragma("unroll") for (int m = 0; m < 4; ++m) _Pragma("unroll") for (int k = 0; k < 2; ++k) dst[m][k] = *(const PG8_LAS bf16x8*)(lds + PG8_SA(b, h) + aoff + m * 2048 + k * 1024); } while (0)
#define PG8_LDB(dst, b, h) do { _Pragma("unroll") for (int n = 0; n < 2; ++n) _Pragma("unroll") for (int k = 0; k < 2; ++k) dst[n][k] = *(const PG8_LAS bf16x8*)(lds + PG8_SB(b, h) + boff + n * 2048 + k * 1024); } while (0)
#define PG8_MMA(ai, bj, At, Bt) do { __builtin_amdgcn_s_setprio(1); _Pragma("unroll") for (int m = 0; m < 4; ++m) _Pragma("unroll") for (int n = 0; n < 2; ++n) _Pragma("unroll") for (int k = 0; k < 2; ++k) \
        acc[ai][bj][m][n] = __builtin_amdgcn_mfma_f32_16x16x32_bf16(Bt[n][k], At[m][k], acc[ai][bj][m][n], 0, 0, 0); __builtin_amdgcn_s_setprio(0); } while (0)
#define PG8_WAIT_V(n) asm volatile("s_waitcnt vmcnt(" #n ")" ::: "memory")
#define PG8_WAIT_L(n) asm volatile("s_waitcnt lgkmcnt(" #n ")" ::: "memory")
#define PG8_BAR __builtin_amdgcn_s_barrier()
#define PG8_SCHED __builtin_amdgcn_sched_barrier(0)
    Unit cur, nxt; int ui = 0;
    if (!p.next(0, cur)) return;
    f32x4 acc[2][2][4][2];
#pragma unroll
    for (int a = 0; a < 2; ++a)
#pragma unroll
        for (int b = 0; b < 2; ++b)
#pragma unroll
            for (int m = 0; m < 4; ++m)
#pragma unroll
                for (int n = 0; n < 2; ++n) acc[a][b][m][n] = (f32x4){0.f, 0.f, 0.f, 0.f};
    bf16x8 At[4][2], B0[2][2], B1[2][2];
    const char* cA = (const char*)p.a_base(cur); const char* cB = (const char*)p.b_base(cur);
    PG8_SETVOA(voA, cur);
    PG8_STAGE_B(PG8_SB(0, 0), cB); PG8_STAGE_B(PG8_SB(0, 1), cB + hstepB); PG8_STAGE_A(PG8_SA(0, 0), cA, voA, 0); PG8_STAGE_A(PG8_SA(0, 1), cA, voA, 1);
    if (wr == 1) PG8_BAR;
    PG8_WAIT_V(2); PG8_BAR;
    PG8_STAGE_B(PG8_SB(1, 0), cB + kstep); PG8_STAGE_A(PG8_SA(1, 0), cA + kstep, voA, 0); PG8_STAGE_B(PG8_SB(1, 1), cB + hstepB + kstep);
    PG8_WAIT_V(6); PG8_BAR;
    for (;;) {
        const bool has_next = p.next(ui + 1, nxt);
        const char* nA = has_next ? (const char*)p.a_base(nxt) : cA; const char* nB = has_next ? (const char*)p.b_base(nxt) : cB;
        if constexpr (P::GATHER) {
            if (has_next) PG8_SETVOA(nvoA, nxt);
            else {
#pragma unroll
                for (int h = 0; h < 2; ++h)
#pragma unroll
                    for (int i = 0; i < 2; ++i) nvoA[h][i] = voA[h][i]; }
        }
#pragma nounroll
        for (int t = 0; t < nt; t += 2) {
            const bool last = (t == nt - 2);
            const char* a1 = cA + (size_t)(t + 1) * kstep;
            const char* a2 = last ? nA : cA + (size_t)(t + 2) * kstep; const char* b2 = last ? nB : cB + (size_t)(t + 2) * kstep;
            const char* a3 = a2 + kstep; const char* b3 = b2 + kstep;
            unsigned wA[2][2];
#pragma unroll
            for (int h = 0; h < 2; ++h)
#pragma unroll
                for (int i = 0; i < 2; ++i) { if constexpr (P::GATHER) wA[h][i] = last ? nvoA[h][i] : voA[h][i]; else wA[h][i] = voA[h][i]; }
            PG8_LDB(B0, 0, 0); PG8_LDB(B1, 0, 1); PG8_SCHED; PG8_LDA(At, 0, 0); PG8_STAGE_A(PG8_SA(1, 1), a1, voA, 1);
            PG8_WAIT_V(8); PG8_WAIT_L(0); PG8_BAR; PG8_MMA(0, 0, At, B0); PG8_MMA(0, 1, At, B1); PG8_BAR; PG8_SCHED;
            PG8_LDA(At, 0, 1); PG8_STAGE_B(PG8_SB(0, 0), b2); PG8_STAGE_B(PG8_SB(0, 1), b2 + hstepB); PG8_STAGE_A(PG8_SA(0, 0), a2, wA, 0);
            PG8_WAIT_V(8); PG8_WAIT_L(0); PG8_BAR; PG8_MMA(1, 0, At, B0); PG8_MMA(1, 1, At, B1); PG8_BAR; PG8_SCHED;
            PG8_LDB(B0, 1, 0); PG8_LDB(B1, 1, 1); PG8_SCHED; PG8_LDA(At, 1, 0); PG8_STAGE_A(PG8_SA(0, 1), a2, wA, 1);
            PG8_WAIT_V(8); PG8_WAIT_L(0); PG8_BAR; PG8_MMA(0, 0, At, B0); PG8_MMA(0, 1, At, B1); PG8_BAR; PG8_SCHED;
            PG8_LDA(At, 1, 1); PG8_STAGE_B(PG8_SB(1, 0), b3); PG8_STAGE_B(PG8_SB(1, 1), b3 + hstepB); PG8_STAGE_A(PG8_SA(1, 0), a3, wA, 0);
            PG8_WAIT_V(8); PG8_WAIT_L(0); PG8_BAR; PG8_MMA(1, 0, At, B0); PG8_MMA(1, 1, At, B1); PG8_BAR; PG8_SCHED;
        }
        if (wr == 0) PG8_BAR;
        p.epi(acc, cur, wr, wc, fr, fq);
        if (!has_next) break;
#pragma unroll
        for (int a = 0; a < 2; ++a)
#pragma unroll
            for (int b = 0; b < 2; ++b)
#pragma unroll
                for (int m = 0; m < 4; ++m)
#pragma unroll
                    for (int n = 0; n < 2; ++n) acc[a][b][m][n] = (f32x4){0.f, 0.f, 0.f, 0.f};
        cur = nxt; cA = nA; cB = nB; ++ui;
        if constexpr (P::GATHER) {
#pragma unroll
            for (int h = 0; h < 2; ++h)
#pragma unroll
                for (int i = 0; i < 2; ++i) voA[h][i] = nvoA[h][i]; }
        if (wr == 1) PG8_BAR;
    }
    PG8_WAIT_V(0);
    PG8_BAR;
#undef PG8_SETVOA
#undef PG8_SA
#undef PG8_SB
#undef PG8_STAGE
#undef PG8_STAGE_A
#undef PG8_STAGE_B
#undef PG8_LDA
#undef PG8_LDB
#undef PG8_MMA
#undef PG8_WAIT_V
#undef PG8_WAIT_L
#undef PG8_BAR
#undef PG8_SCHED
}
}
using pg8::bf16_t; using pg8::f32x4; using pg8::f32x2; using pg8::u32x4; using pg8::u32x2; using pg8::bf16x8; using pg8::Unit;
using pg8::cvt_pk_bf16; using pg8::bf_lo; using pg8::bf_hi; using pg8::gelu_tanh; using pg8::fast_sigmoid;

constexpr int NWAVES = 8;
constexpr int D = 1024, NB = 4, SEQ = 8192, CTXL = 256;
constexpr int MROWS = NB * SEQ, CROWS = NB * CTXL, XROWS = MROWS + CROWS;
constexpr int S5W = 256, GMW = 768, INC = 1792, NE = 16, CAP = 1024, DFF = 2816, NHEAD = 6;
constexpr int TCH = 64, NCL = MROWS / TCH, NCC = CROWS / TCH;
constexpr int AG_ROWS = 768, AG_LD = 1280, BT_LD = 1280;
constexpr float ALPHA = 1.189207115f;
constexpr float LN_EPS = 1e-6f;
constexpr int NPH = 13;
constexpr int N_LAUNCHES = MK_N_LAUNCHES;
static_assert(N_LAUNCHES == 1 || N_LAUNCHES == NPH, "MK_N_LAUNCHES is 1 or NPH");

constexpr size_t MiB = 1u << 20;
constexpr size_t WS_CTL = 0, CTL_ZERO_BYTES = 64 * 1024;
constexpr size_t WS_MOD = 1 * MiB;
constexpr size_t WS_WINT = 2 * MiB;
constexpr size_t WS_WOUTT = 6 * MiB;
constexpr size_t WS_WGLUT = 8 * MiB;
constexpr size_t WS_WSGM = 8 * MiB + 256 * 1024;
constexpr size_t WS_SEL = 9 * MiB;
constexpr size_t WS_GATE = 9 * MiB + 512 * 1024;
constexpr size_t WS_AFF = 10 * MiB;
constexpr size_t WS_INV = 12 * MiB;
constexpr size_t WS_KTAB = 14 * MiB;
constexpr size_t WS_HBF = 16 * MiB;
constexpr size_t WS_WGU = 80 * MiB;
constexpr size_t WS_YEXP = WS_WGU;
constexpr size_t WS_WDN = 256 * MiB;
constexpr size_t WS_BIG = 344 * MiB;
constexpr size_t WS_HID = WS_BIG;
constexpr size_t WS_XM = WS_BIG;
constexpr size_t WS_ZG = WS_BIG + 66 * MiB;
constexpr size_t WS_AG = WS_BIG + 162 * MiB;
constexpr size_t WS_BTG = WS_BIG + 192 * MiB;
constexpr size_t WS_LOC = WS_BIG + 242 * MiB;
constexpr size_t WS_GY = WS_BIG + 254 * MiB;
constexpr size_t WS_AOUT = WS_BIG + 270 * MiB;
constexpr size_t WS_END = WS_BIG + 352 * MiB;
static_assert(WS_AOUT + 64 * MiB <= WS_END, "temporaries inside the HID overlay");
constexpr int CW_BAR = 1024;

constexpr int RING_OFF = 0, RING_BYTES = 131072;
constexpr int LDSCTL_OFF = RING_BYTES, MISC_OFF = LDSCTL_OFF + 320;
constexpr int LDS_BYTES = 147456;

#define GAS __attribute__((address_space(1)))
#define LAS __attribute__((address_space(3)))
typedef GAS unsigned gu32;
#define RLX_AGENT __ATOMIC_RELAXED, __HIP_MEMORY_SCOPE_AGENT
#define LDS_WAIT() asm volatile("s_waitcnt lgkmcnt(0)" ::: "memory")
__device__ __forceinline__ unsigned f2bf(float f) { unsigned u = __builtin_bit_cast(unsigned, f); return (u + 0x7fffu + ((u >> 16) & 1u)) >> 16; }
__device__ __forceinline__ unsigned pk2(float lo, float hi) { return f2bf(lo) | (f2bf(hi) << 16); }
__device__ __forceinline__ float wave_sum(float v) {
#pragma unroll
    for (int o = 1; o < 64; o <<= 1) v += __shfl_xor(v, o);
    return v;
}

#define XB_TMO      128
#define XB_XCNT(j)  (256  + 64 * (j))
#define XB_XSUB(j)  (1280 + 64 * (j))
#define XB_XGEN(j)  (2304 + 64 * (j))
#define XB_TOP      3328
#define XB_TOPGEN   3392
#define XCD_BAR_WORDS 3456
#define XB_SPIN_CAP (1u << 18)
__device__ __forceinline__ unsigned xb_ld(unsigned* p)              { return __hip_atomic_load(p, __ATOMIC_RELAXED, __HIP_MEMORY_SCOPE_AGENT); }
__device__ __forceinline__ unsigned xb_add(unsigned* p, unsigned v) { return __hip_atomic_fetch_add(p, v, __ATOMIC_RELAXED, __HIP_MEMORY_SCOPE_AGENT); }
__device__ __forceinline__ unsigned xb_xcc_id() { return (unsigned)__builtin_amdgcn_s_getreg((3 << 11) | 20) & 0xFu; }
#define XB_SPIN(cond, bar) do { unsigned _sp = 0; while (cond) { __builtin_amdgcn_s_sleep(1); \
    if ((++_sp & 255u) == 0u) { if (xb_ld(&(bar)[XB_TMO])) break; if (_sp > XB_SPIN_CAP) { atomicAdd(&(bar)[XB_TMO], 1u); break; } } } } while (0)
struct XcdBarrier { unsigned* bar; unsigned x; volatile LAS unsigned* st; };
__device__ __forceinline__ XcdBarrier xcd_barrier_post(unsigned* bar, volatile LAS unsigned* st) {
    XcdBarrier b; b.bar = bar; b.x = xb_xcc_id(); b.st = st;
    if (threadIdx.x == 0) (void)xb_add(&bar[XB_XCNT(b.x)], 1u);
    return b;
}
__device__ __forceinline__ void xcd_barrier_complete(unsigned* bar, unsigned x, unsigned& nloc, unsigned& nx) {
    const unsigned G = gridDim.x * gridDim.y * gridDim.z;
    unsigned sum, cnt, mine, sp = 0u;
    for (;;) {
        sum = 0u; cnt = 0u; mine = 0u;
#pragma unroll
        for (unsigned j = 0; j < 16; ++j) { const unsigned c = xb_ld(&bar[XB_XCNT(j)]); sum += c; cnt += (c > 0u) ? 1u : 0u; mine = (j == x) ? c : mine; }
        if (sum == G) break;
        __builtin_amdgcn_s_sleep(1);
        if ((++sp & 255u) == 0u) { if (xb_ld(&bar[XB_TMO])) break; if (sp > XB_SPIN_CAP) { atomicAdd(&bar[XB_TMO], 1u); break; } }
    }
    nloc = mine > 0u ? mine : 1u; nx = cnt > 0u ? cnt : 1u;
}
__device__ __forceinline__ void xcd_barrier(const XcdBarrier& b) {
    asm volatile("s_waitcnt vmcnt(0)" ::: "memory");
    __syncthreads();
    if (threadIdx.x == 0) {
        unsigned* bar = b.bar;
        __builtin_amdgcn_s_waitcnt(0);
        unsigned nloc = b.st[0], nx = b.st[1];
        if (nloc == 0u) { xcd_barrier_complete(bar, b.x, nloc, nx); b.st[0] = nloc; b.st[1] = nx; }
        const unsigned old = xb_add(&bar[XB_XSUB(b.x)], 1u);
        const unsigned gen = old / nloc;
        if (old + 1u == (gen + 1u) * nloc) {
            __builtin_amdgcn_fence(__ATOMIC_RELEASE, "agent");
            asm volatile("s_waitcnt vmcnt(0)" ::: "memory");
            const unsigned og = xb_add(&bar[XB_TOP], 1u);
            const unsigned tg = og / nx;
            if (og + 1u == (tg + 1u) * nx) xb_add(&bar[XB_TOPGEN], 1u);
            else XB_SPIN(xb_ld(&bar[XB_TOPGEN]) == tg, bar);
            __builtin_amdgcn_fence(__ATOMIC_ACQUIRE, "agent");
            xb_add(&bar[XB_XGEN(b.x)], 1u);
            asm volatile("s_waitcnt vmcnt(0)" ::: "memory");
        } else {
            XB_SPIN(xb_ld(&bar[XB_XGEN(b.x)]) == gen, bar);
            __builtin_amdgcn_fence(__ATOMIC_ACQUIRE, "agent");
            asm volatile("s_waitcnt vmcnt(0)" ::: "memory");
        }
    }
    __syncthreads();
}

struct Args {
    const float *x, *c, *ctx, *c_ctx, *w_ada, *b_ada, *w_in, *gm_ws, *gm_bs, *a_re, *a_im, *log_step, *b_re, *b_im, *c_re, *c_im, *s5_d, *w_glu, *b_glu, *w_out,
                *ln1_g, *ln1_b, *w_router, *w_gate, *w_up, *w_down, *ln2_g, *ln2_b;
    float* out; unsigned char* ws; int ph_lo, ph_hi;
};

struct PInProj {
    static constexpr bool PERM = true, GATHER = false; static constexpr int K = D, LDA = D, LDB = D;
    const bf16_t* A; const bf16_t* Bt; bf16_t* AG; bf16_t* ZG; int G, c;
    __device__ __forceinline__ bool next(int i, Unit& u) const { const int L = i * G + c; if (L >= 900) return false; if (L < 4) { u.pm = 128 + L; u.pn = 0; } else pg8::tile_order(L - 4, 128, 7, u.pm, u.pn); u.z = 0; return true; }
    __device__ __forceinline__ const bf16_t* a_base(const Unit& u) const { return A + (size_t)u.pm * 256 * D; }
    __device__ __forceinline__ const bf16_t* b_base(const Unit& u) const { return Bt + (size_t)u.pn * 256 * D; }
    __device__ __forceinline__ int a_row(const Unit&, int r) const { return r; }
    __device__ __forceinline__ void epi(const f32x4 (&acc)[2][2][4][2], const Unit& u, int wr, int wc, int fr, int fq) const {
        const int row0 = u.pm * 256 + wr * 64 + fr;
        if (u.pn == 0) {
#pragma unroll
            for (int ai = 0; ai < 2; ++ai)
#pragma unroll
                for (int m = 0; m < 4; ++m) { const int row = row0 + ai * 128 + m * 16; const int chunk = row < MROWS ? (row >> 6) : (NCL + ((row - MROWS) >> 6)); const int ti = row & 63;
#pragma unroll
                    for (int bj = 0; bj < 2; ++bj) { const int c0 = bj * 128 + wc * 32 + 8 * fq, g = c0 >> 4, h0 = c0 & 15; const f32x4 v0 = acc[ai][bj][m][0], v1 = acc[ai][bj][m][1];
                        u32x4 w; w.x = cvt_pk_bf16(v0[0], v0[1]); w.y = cvt_pk_bf16(v0[2], v0[3]); w.z = cvt_pk_bf16(v1[0], v1[1]); w.w = cvt_pk_bf16(v1[2], v1[3]);
                        *(u32x4*)(AG + ((size_t)(g * AG_ROWS + chunk) * AG_LD + ti * 16 + h0)) = w; } }
        } else {
            const int col0 = (u.pn - 1) * 256 + wc * 32 + 8 * fq;
#pragma unroll
            for (int ai = 0; ai < 2; ++ai)
#pragma unroll
                for (int m = 0; m < 4; ++m) { bf16_t* rowp = ZG + (size_t)(row0 + ai * 128 + m * 16) * 1536 + col0;
#pragma unroll
                    for (int bj = 0; bj < 2; ++bj) { const f32x4 v0 = acc[ai][bj][m][0], v1 = acc[ai][bj][m][1];
                        u32x4 w; w.x = cvt_pk_bf16(gelu_tanh(v0[0]), gelu_tanh(v0[1])); w.y = cvt_pk_bf16(gelu_tanh(v0[2]), gelu_tanh(v0[3]));
                        w.z = cvt_pk_bf16(gelu_tanh(v1[0]), gelu_tanh(v1[1])); w.w = cvt_pk_bf16(gelu_tanh(v1[2]), gelu_tanh(v1[3]));
                        *(u32x4*)(rowp + bj * 128) = w; } }
        }
    }
};
struct PLoc {
    static constexpr bool PERM = false, GATHER = false; static constexpr int K = 1024, LDA = AG_LD, LDB = BT_LD;
    const bf16_t* AG; const bf16_t* BTG; float* LOC; int G, c;
    __device__ __forceinline__ bool next(int i, Unit& u) const { const int L = i * G + c; if (L >= 48) return false; u.z = L / 3; u.pm = L % 3; u.pn = 0; return true; }
    __device__ __forceinline__ const bf16_t* a_base(const Unit& u) const { return AG + (size_t)(u.z * AG_ROWS + u.pm * 256) * AG_LD; }
    __device__ __forceinline__ const bf16_t* b_base(const Unit& u) const { return BTG + (size_t)(u.z * BT_LD + 1024) * BT_LD; }
    __device__ __forceinline__ int a_row(const Unit&, int r) const { return r; }
    __device__ __forceinline__ void epi(const f32x4 (&acc)[2][2][4][2], const Unit& u, int wr, int wc, int fr, int fq) const {
        const int row0 = u.pm * 256 + wr * 64 + fr, col0 = wc * 32 + 4 * fq;
#pragma unroll
        for (int ai = 0; ai < 2; ++ai)
#pragma unroll
            for (int m = 0; m < 4; ++m) { float* rowp = LOC + (size_t)(u.z * AG_ROWS + row0 + ai * 128 + m * 16) * 256 + col0;
#pragma unroll
                for (int bj = 0; bj < 2; ++bj)
#pragma unroll
                    for (int n = 0; n < 2; ++n) *(f32x4*)(rowp + bj * 128 + n * 16) = acc[ai][bj][m][n]; }
    }
};
struct PS5Main {
    static constexpr bool PERM = true, GATHER = false; static constexpr int K = 1280, LDA = AG_LD, LDB = BT_LD;
    const bf16_t* AG; const bf16_t* BTG; bf16_t* GY; int G, c;
    __device__ __forceinline__ bool next(int i, Unit& u) const { const int L = i * G + c; if (L >= 128) return false; u.z = L >> 3; u.pm = (L >> 2) & 1; u.pn = L & 3; return true; }
    __device__ __forceinline__ const bf16_t* a_base(const Unit& u) const { return AG + (size_t)(u.z * AG_ROWS + u.pm * 256) * AG_LD; }
    __device__ __forceinline__ const bf16_t* b_base(const Unit& u) const { return BTG + (size_t)(u.z * BT_LD + u.pn * 256) * BT_LD; }
    __device__ __forceinline__ int a_row(const Unit&, int r) const { return r; }
    __device__ __forceinline__ void epi(const f32x4 (&acc)[2][2][4][2], const Unit& u, int wr, int wc, int fr, int fq) const {
        const int chunk0 = u.pm * 256 + wr * 64 + fr;
#pragma unroll
        for (int ai = 0; ai < 2; ++ai)
#pragma unroll
            for (int m = 0; m < 4; ++m) { const int chunk = chunk0 + ai * 128 + m * 16;
#pragma unroll
                for (int bj = 0; bj < 2; ++bj) { const int n0 = u.pn * 256 + bj * 128 + wc * 32 + 8 * fq, j = n0 >> 4, h0 = n0 & 15; const f32x4 v0 = acc[ai][bj][m][0], v1 = acc[ai][bj][m][1];
                    u32x4 w; w.x = cvt_pk_bf16(gelu_tanh(v0[0]), gelu_tanh(v0[1])); w.y = cvt_pk_bf16(gelu_tanh(v0[2]), gelu_tanh(v0[3]));
                    w.z = cvt_pk_bf16(gelu_tanh(v1[0]), gelu_tanh(v1[1])); w.w = cvt_pk_bf16(gelu_tanh(v1[2]), gelu_tanh(v1[3]));
                    *(u32x4*)(GY + ((size_t)(chunk * TCH + j) * S5W + u.z * 16 + h0)) = w; } }
    }
};
struct PGlu {
    static constexpr bool PERM = true, GATHER = false; static constexpr int K = 256, LDA = 256, LDB = 256;
    const bf16_t* GY; const bf16_t* Bt; const float* b_glu; bf16_t* AOUT; int G, c;
    __device__ __forceinline__ bool next(int i, Unit& u) const { const int L = i * G + c; if (L >= 128) return false; u.pm = L; u.pn = 0; u.z = 0; return true; }
    __device__ __forceinline__ const bf16_t* a_base(const Unit& u) const { return GY + (size_t)u.pm * 256 * 256; }
    __device__ __forceinline__ const bf16_t* b_base(const Unit&) const { return Bt; }
    __device__ __forceinline__ int a_row(const Unit&, int r) const { return r; }
    __device__ __forceinline__ void epi(const f32x4 (&acc)[2][2][4][2], const Unit& u, int wr, int wc, int fr, int fq) const {
        const int row0 = u.pm * 256 + wr * 64 + fr, col0 = wc * 32 + 8 * fq;
        f32x4 bv[2][2];
#pragma unroll
        for (int bj = 0; bj < 2; ++bj)
#pragma unroll
            for (int n = 0; n < 2; ++n) bv[bj][n] = *(const f32x4*)(b_glu + col0 + bj * 128 + 4 * n);
#pragma unroll
        for (int ai = 0; ai < 2; ++ai)
#pragma unroll
            for (int m = 0; m < 4; ++m) { const int row = row0 + ai * 128 + m * 16;
#pragma unroll
                for (int bj = 0; bj < 2; ++bj) { const u32x4 gw = *(const u32x4*)(GY + (size_t)row * 256 + col0 + bj * 128);
                    const f32x4 v0 = acc[ai][bj][m][0] + bv[bj][0], v1 = acc[ai][bj][m][1] + bv[bj][1];
                    u32x4 w; w.x = cvt_pk_bf16(bf_lo(gw.x) * fast_sigmoid(v0[0]), bf_hi(gw.x) * fast_sigmoid(v0[1])); w.y = cvt_pk_bf16(bf_lo(gw.y) * fast_sigmoid(v0[2]), bf_hi(gw.y) * fast_sigmoid(v0[3]));
                    w.z = cvt_pk_bf16(bf_lo(gw.z) * fast_sigmoid(v1[0]), bf_hi(gw.z) * fast_sigmoid(v1[1])); w.w = cvt_pk_bf16(bf_lo(gw.w) * fast_sigmoid(v1[2]), bf_hi(gw.w) * fast_sigmoid(v1[3]));
                    *(u32x4*)(AOUT + (size_t)row * D + col0 + bj * 128) = w; }
                asm volatile("" ::: "memory"); }
    }
};
struct POutProj {
    static constexpr bool PERM = false, GATHER = false; static constexpr int K = D, LDA = D, LDB = D;
    const bf16_t* A; const bf16_t* Bt; const float* x; const float* mod; float* Y; int G, c;
    __device__ __forceinline__ bool next(int i, Unit& u) const { const int L = i * G + c; if (L >= 512) return false; pg8::tile_order(L, 128, 4, u.pm, u.pn); u.z = 0; return true; }
    __device__ __forceinline__ const bf16_t* a_base(const Unit& u) const { return A + (size_t)u.pm * 256 * D; }
    __device__ __forceinline__ const bf16_t* b_base(const Unit& u) const { return Bt + (size_t)u.pn * 256 * D; }
    __device__ __forceinline__ int a_row(const Unit&, int r) const { return r; }
    __device__ __forceinline__ void epi(const f32x4 (&acc)[2][2][4][2], const Unit& u, int wr, int wc, int fr, int fq) const {
        const int row0 = u.pm * 256 + wr * 64 + fr, col0 = u.pn * 256 + wc * 32 + 4 * fq;
        const float* g1 = mod + (size_t)(u.pm >> 5) * 6144 + 2048;
        f32x4 gv[2][2];
#pragma unroll
        for (int bj = 0; bj < 2; ++bj)
#pragma unroll
            for (int n = 0; n < 2; ++n) gv[bj][n] = *(const f32x4*)(g1 + col0 + bj * 128 + n * 16);
#pragma unroll
        for (int ai = 0; ai < 2; ++ai)
#pragma unroll
            for (int m = 0; m < 4; ++m) { const size_t off = (size_t)(row0 + ai * 128 + m * 16) * D + col0;
#pragma unroll
                for (int bj = 0; bj < 2; ++bj)
#pragma unroll
                    for (int n = 0; n < 2; ++n) { const f32x4 xv = *(const f32x4*)(x + off + bj * 128 + n * 16); *(f32x4*)(Y + off + bj * 128 + n * 16) = xv * ALPHA + gv[bj][n] * acc[ai][bj][m][n]; }
                asm volatile("" ::: "memory"); }
    }
};
__device__ __forceinline__ void moe_tile(int pmx, int& e, int& rowbase) { e = pmx >> 4; const int b = (pmx >> 2) & 3, mt = pmx & 3; rowbase = (b * 16 + e) * CAP + mt * 256; }
struct PGateUp {
    static constexpr bool PERM = true, GATHER = true; static constexpr int K = D, LDA = D, LDB = D;
    const bf16_t* HBF; const bf16_t* WGU; const int* SEL; bf16_t* HID; int G, c;
    __device__ __forceinline__ bool next(int i, Unit& u) const { const int L = i * G + c; if (L >= 256 * 22) return false; pg8::tile_order(L, 256, 22, u.pm, u.pn); int e, rb; moe_tile(u.pm, e, rb); u.z = rb; return true; }
    __device__ __forceinline__ const bf16_t* a_base(const Unit&) const { return HBF; }
    __device__ __forceinline__ const bf16_t* b_base(const Unit& u) const { return WGU + ((size_t)(u.pm >> 4) * 5632 + (size_t)u.pn * 256) * D; }
    __device__ __forceinline__ int a_row(const Unit& u, int r) const { return SEL[u.z + r]; }
    __device__ __forceinline__ void epi(const f32x4 (&acc)[2][2][4][2], const Unit& u, int wr, int wc, int fr, int fq) const {
        const int row0 = u.z + wr * 64 + fr, col0 = u.pn * 128 + wc * 32 + 8 * fq;
#pragma unroll
        for (int ai = 0; ai < 2; ++ai)
#pragma unroll
            for (int m = 0; m < 4; ++m) { bf16_t* rowp = HID + (size_t)(row0 + ai * 128 + m * 16) * DFF + col0;
                const f32x4 g0 = acc[ai][0][m][0], g1 = acc[ai][0][m][1], u0 = acc[ai][1][m][0], u1 = acc[ai][1][m][1];
                u32x4 w; w.x = cvt_pk_bf16(g0[0] * fast_sigmoid(g0[0]) * u0[0], g0[1] * fast_sigmoid(g0[1]) * u0[1]); w.y = cvt_pk_bf16(g0[2] * fast_sigmoid(g0[2]) * u0[2], g0[3] * fast_sigmoid(g0[3]) * u0[3]);
                w.z = cvt_pk_bf16(g1[0] * fast_sigmoid(g1[0]) * u1[0], g1[1] * fast_sigmoid(g1[1]) * u1[1]); w.w = cvt_pk_bf16(g1[2] * fast_sigmoid(g1[2]) * u1[2], g1[3] * fast_sigmoid(g1[3]) * u1[3]);
                *(u32x4*)rowp = w; }
    }
};
struct PDown {
    static constexpr bool PERM = true, GATHER = false; static constexpr int K = DFF, LDA = DFF, LDB = DFF;
    const bf16_t* HID; const bf16_t* WDN; const float* GATE; bf16_t* YEXP; int G, c;
    __device__ __forceinline__ bool next(int i, Unit& u) const { const int L = i * G + c; if (L >= 256 * 4) return false; pg8::tile_order(L, 256, 4, u.pm, u.pn); int e, rb; moe_tile(u.pm, e, rb); u.z = rb; return true; }
    __device__ __forceinline__ const bf16_t* a_base(const Unit& u) const { return HID + (size_t)u.z * DFF; }
    __device__ __forceinline__ const bf16_t* b_base(const Unit& u) const { return WDN + ((size_t)(u.pm >> 4) * D + (size_t)u.pn * 256) * DFF; }
    __device__ __forceinline__ int a_row(const Unit&, int r) const { return r; }
    __device__ __forceinline__ void epi(const f32x4 (&acc)[2][2][4][2], const Unit& u, int wr, int wc, int fr, int fq) const {
        const int row0 = u.z + wr * 64 + fr, col0 = u.pn * 256 + wc * 32 + 8 * fq;
#pragma unroll
        for (int ai = 0; ai < 2; ++ai)
#pragma unroll
            for (int m = 0; m < 4; ++m) { const int row = row0 + ai * 128 + m * 16; const float gt = GATE[row]; bf16_t* rowp = YEXP + (size_t)row * D + col0;
#pragma unroll
                for (int bj = 0; bj < 2; ++bj) { const f32x4 v0 = acc[ai][bj][m][0] * gt, v1 = acc[ai][bj][m][1] * gt;
                    u32x4 w; w.x = cvt_pk_bf16(v0[0], v0[1]); w.y = cvt_pk_bf16(v0[2], v0[3]); w.z = cvt_pk_bf16(v1[0], v1[1]); w.w = cvt_pk_bf16(v1[2], v1[3]);
                    *(u32x4*)(rowp + bj * 128) = w; } }
    }
};

struct Ctx { LAS unsigned char* lds; int tid, lane, wave, vcu, G; };

__device__ __forceinline__ void s5_param(const Args& a, int d, int g, int p, float& lr, float& li, float& cbr, float& cbi) {
    const float step = expf(a.log_step[d * 16 + g]); const float ar = a.a_re[(d * 16 + g) * 64 + p], ai = a.a_im[(d * 16 + g) * 64 + p];
    lr = ar * step; li = ai * step;
    float s, c; sincosf(li, &s, &c);
    const float em1 = expm1f(lr), e = em1 + 1.0f; const float s2 = sinf(0.5f * li); const float cm1 = -2.0f * s2 * s2;
    const float nr = em1 * c + cm1, ni = e * s, den = ar * ar + ai * ai;
    cbr = (nr * ar + ni * ai) / den; cbi = (ni * ar - nr * ai) / den;
}
__device__ __forceinline__ void cpow(float lr, float li, float e, float& pr, float& pi) { const float m = expf(lr * e); float s, c; sincosf(li * e, &s, &c); pr = m * c; pi = m * s; }

__device__ __forceinline__ void transpose_item(const float* W, int N, bf16_t* WT, int ldt, int k0, int n0, int row_off, LAS float* scr, int lane) {
#pragma unroll 8
    for (int i = 0; i < 32; ++i) { const int kk = 2 * i + (lane >> 5); scr[kk * 33 + (lane & 31)] = W[(size_t)(k0 + kk) * N + n0 + (lane & 31)]; }
    LDS_WAIT(); asm volatile("" ::: "memory");
    const int c = lane & 7;
#pragma unroll
    for (int j = 0; j < 4; ++j) { const int n = (lane >> 3) + 8 * j; const LAS float* s = scr + (8 * c) * 33 + n;
        u32x4 o; o.x = pk2(s[0 * 33], s[1 * 33]); o.y = pk2(s[2 * 33], s[3 * 33]); o.z = pk2(s[4 * 33], s[5 * 33]); o.w = pk2(s[6 * 33], s[7 * 33]);
        *(u32x4*)(WT + (size_t)(row_off + n) * ldt + k0 + 8 * c) = o; }
    LDS_WAIT(); asm volatile("" ::: "memory");
}

__device__ __forceinline__ void phase0(const Args& a, const Ctx& F) {
    unsigned char* ws = a.ws;
    for (int unit = F.vcu; unit < 96 + 1024; unit += F.G) {
        if (unit < 96) {
            LAS float* S = (LAS float*)(F.lds);
            LAS float* R = (LAS float*)(F.lds + 5 * 1024 * 4);
            for (int i = F.tid; i < 5 * 1024; i += 512) { const int v = i >> 10, k = i & 1023; const float cv = v < 4 ? a.c[v * 1024 + k] : a.c_ctx[k]; S[i] = cv / (1.0f + expf(-cv)); }
            __syncthreads();
            const int n = unit * 64 + F.lane; float acc[5] = {0.f, 0.f, 0.f, 0.f, 0.f};
            const float* wp = a.w_ada + (size_t)(F.wave * 128) * 6144 + n;
#pragma unroll 8
            for (int k = 0; k < 128; ++k) { const float wv = wp[(size_t)k * 6144];
#pragma unroll
                for (int v = 0; v < 5; ++v) acc[v] += S[v * 1024 + F.wave * 128 + k] * wv; }
#pragma unroll
            for (int v = 0; v < 5; ++v) R[(F.wave * 5 + v) * 64 + F.lane] = acc[v];
            __syncthreads();
            if (F.tid < 320) { const int v = F.tid >> 6; float s = a.b_ada[n];
#pragma unroll
                for (int w = 0; w < 8; ++w) s += R[(w * 5 + v) * 64 + F.lane];
                ((float*)(ws + WS_MOD))[v * 6144 + n] = s; }
            __syncthreads();
        } else {
            const int u2 = unit - 96, d = u2 >> 9, g = (u2 >> 5) & 15, dl = 2 * (u2 & 31) + (F.tid >> 8), t = F.tid & 255, h = t >> 4, hp = t & 15;
            LAS float* PB = (LAS float*)(F.lds);
            if (t < 64) { float lr, li, cbr, cbi, pr, pi; s5_param(a, d, g, t, lr, li, cbr, cbi); cpow(lr, li, (float)dl, pr, pi);
                PB[((F.tid >> 8) * 64 + t) * 2 + 0] = pr * cbr - pi * cbi; PB[((F.tid >> 8) * 64 + t) * 2 + 1] = pr * cbi + pi * cbr; }
            __syncthreads();
            const float* cre = a.c_re + ((size_t)(d * 16 + g) * 16 + h) * 64; const float* cim = a.c_im + ((size_t)(d * 16 + g) * 16 + h) * 64;
            const float* bre = a.b_re + (size_t)(d * 16 + g) * 64 * 16 + hp; const float* bim = a.b_im + (size_t)(d * 16 + g) * 64 * 16 + hp;
            float sum = 0.f;
#pragma unroll 8
            for (int p = 0; p < 64; ++p) { const float pbr = PB[((F.tid >> 8) * 64 + p) * 2], pbi = PB[((F.tid >> 8) * 64 + p) * 2 + 1]; const float cr = cre[p], ci = cim[p];
                const float xr = cr * pbr - ci * pbi, xi = cr * pbi + ci * pbr; sum += xr * bre[p * 16] - xi * bim[p * 16]; }
            ((float*)(ws + WS_KTAB))[((size_t)((d * 16 + g) * 64 + dl)) * 256 + t] = sum;
            __syncthreads();
        }
    }
    LAS float* scr = (LAS float*)(F.lds + F.wave * 16384);
    const int gw = F.vcu * NWAVES + F.wave, NGW = F.G * NWAVES;
    constexpr int I_IN = 16 * 56, I_OUT = 16 * 32, I_GLU = 4 * 8, I_E = 16 * 88  , I_MOE = 16 * I_E;
    constexpr int NITEMS = I_IN + I_OUT + I_GLU + 3 * I_MOE;
    for (int it = gw; it < NITEMS; it += NGW) {
        int r = it;
        if (r < I_IN) { const int kb = r / 56, nb = r % 56; transpose_item(a.w_in, INC, (bf16_t*)(ws + WS_WINT), D, 64 * kb, 32 * nb, 32 * nb, scr, F.lane); continue; } r -= I_IN;
        if (r < I_OUT) { const int kb = r / 32, nb = r % 32; transpose_item(a.w_out, D, (bf16_t*)(ws + WS_WOUTT), D, 64 * kb, 32 * nb, 32 * nb, scr, F.lane); continue; } r -= I_OUT;
        if (r < I_GLU) { const int kb = r / 8, nb = r % 8; transpose_item(a.w_glu, S5W, (bf16_t*)(ws + WS_WGLUT), S5W, 64 * kb, 32 * nb, 32 * nb, scr, F.lane); continue; } r -= I_GLU;
        if (r < 2 * I_MOE) { const int s = r / I_MOE; r -= s * I_MOE; const int e = r / I_E, rr = r % I_E, kb = rr / 88, nb = rr % 88, n0 = 32 * nb;
            transpose_item((s ? a.w_up : a.w_gate) + (size_t)e * D * DFF, DFF, (bf16_t*)(ws + WS_WGU) + (size_t)e * 5632 * D, D, 64 * kb, n0, 256 * (n0 >> 7) + 128 * s + (n0 & 127), scr, F.lane); continue; }
        r -= 2 * I_MOE;
        { const int e = r / I_E, rr = r % I_E, kb = rr / 32, nb = rr % 32;
            transpose_item(a.w_down + (size_t)e * DFF * D, D, (bf16_t*)(ws + WS_WDN) + (size_t)e * D * DFF, DFF, 64 * kb, 32 * nb, 32 * nb, scr, F.lane); }
    }
    for (int i = (F.vcu * 512 + F.tid) * 4; i < NHEAD * 128 * 128; i += F.G * 512 * 4) { const f32x4 v = *(const f32x4*)(a.gm_ws + i); u32x2 o; o.x = pk2(v[0], v[1]); o.y = pk2(v[2], v[3]); *(u32x2*)((bf16_t*)(ws + WS_WSGM) + i) = o; }
}

__device__ __forceinline__ void modulate_row_bf16(const float* xrow, const float* sh, const float* sc, bf16_t* orow, int lane) {
    const f32x4* xr = (const f32x4*)xrow + lane;
    f32x4 v[4]; float s = 0.f;
#pragma unroll
    for (int j = 0; j < 4; ++j) { v[j] = xr[64 * j]; s += (v[j].x + v[j].y) + (v[j].z + v[j].w); }
    const float mean = wave_sum(s) * (1.f / D); float s2 = 0.f;
#pragma unroll
    for (int j = 0; j < 4; ++j) { v[j] = v[j] - mean; s2 += (v[j].x * v[j].x + v[j].y * v[j].y) + (v[j].z * v[j].z + v[j].w * v[j].w); }
    const float rstd = 1.f / sqrtf(wave_sum(s2) * (1.f / D) + LN_EPS);
    unsigned long long* o8 = (unsigned long long*)orow + lane;
#pragma unroll
    for (int j = 0; j < 4; ++j) { const f32x4 sv = ((const f32x4*)sh)[lane + 64 * j], cv = ((const f32x4*)sc)[lane + 64 * j]; const f32x4 o = v[j] * rstd * (cv + 1.0f) + sv;
        o8[64 * j] = (unsigned long long)pk2(o.x, o.y) | ((unsigned long long)pk2(o.z, o.w) << 32); }
}

__device__ __forceinline__ void phase1(const Args& a, const Ctx& F) {
    unsigned char* ws = a.ws; const float* mod = (const float*)(ws + WS_MOD);
    const int gw = F.vcu * NWAVES + F.wave, NGW = F.G * NWAVES;
    for (int m = gw; m < XROWS; m += NGW) {
        const int mi = m < MROWS ? (m >> 13) : 4; const float* src = m < MROWS ? a.x + (size_t)m * D : a.ctx + (size_t)(m - MROWS) * D;
        modulate_row_bf16(src, mod + mi * 6144, mod + mi * 6144 + 1024, (bf16_t*)(ws + WS_XM) + (size_t)m * D, F.lane);
    }
    const float* KT = (const float*)(ws + WS_KTAB);
    const int gt = F.vcu * 512 + F.tid, NGT = F.G * 512;
    constexpr int ITEMS_PER_G = 1280 * 160;
    for (int it = gt; it < 16 * ITEMS_PER_G; it += NGT) {
        const int g = it / ITEMS_PER_G, r = it % ITEMS_PER_G, n = r / 160, kb = r % 160, k0 = kb * 8;
        float o[8];
        if (n < 1024) {
            const int j = n >> 4, h = n & 15;
            if (k0 < 1024) {
                const int i = k0 >> 4, hp0 = k0 & 15;
#pragma unroll
                for (int e = 0; e < 8; ++e) o[e] = 0.f;
                if (i <= j) { const float* kf = KT + ((size_t)((0 * 16 + g) * 64 + (j - i))) * 256 + h * 16 + hp0;
#pragma unroll
                    for (int e = 0; e < 8; ++e) o[e] += kf[e]; }
                if (i >= j) { const float* kb2 = KT + ((size_t)((1 * 16 + g) * 64 + (i - j))) * 256 + h * 16 + hp0;
#pragma unroll
                    for (int e = 0; e < 8; ++e) o[e] += kb2[e]; }
                if (i == j && h >= hp0 && h < hp0 + 8) { const float dv = a.s5_d[g * 16 + h];
#pragma unroll
                    for (int e = 0; e < 8; ++e) o[e] += (hp0 + e == h) ? dv : 0.f; }
            } else {
                const int q0 = k0 - 1024, d = q0 >> 7, part = (q0 >> 6) & 1, p0 = q0 & 63; const float ex = d == 0 ? (float)(j + 1) : (float)(TCH - j);
#pragma unroll
                for (int e = 0; e < 8; ++e) { const int p = p0 + e; float lr, li, cbr, cbi, pr, pi; s5_param(a, d, g, p, lr, li, cbr, cbi); cpow(lr, li, ex, pr, pi);
                    const float cr = a.c_re[((size_t)(d * 16 + g) * 16 + h) * 64 + p], ci = a.c_im[((size_t)(d * 16 + g) * 16 + h) * 64 + p];
                    o[e] = part == 0 ? (cr * pr - ci * pi) : -(cr * pi + ci * pr); }
            }
        } else {
            if (k0 < 1024) {
                const int q = n - 1024, d = q >> 7, part = (q >> 6) & 1, p = q & 63, i = k0 >> 4, hp0 = k0 & 15; const float ex = d == 0 ? (float)(TCH - 1 - i) : (float)i;
                float lr, li, cbr, cbi, pr, pi; s5_param(a, d, g, p, lr, li, cbr, cbi); cpow(lr, li, ex, pr, pi);
                const float wr_ = pr * cbr - pi * cbi, wi_ = pr * cbi + pi * cbr;
#pragma unroll
                for (int e = 0; e < 8; ++e) { const float br = a.b_re[((size_t)(d * 16 + g) * 64 + p) * 16 + hp0 + e], bi = a.b_im[((size_t)(d * 16 + g) * 64 + p) * 16 + hp0 + e];
                    o[e] = part == 0 ? (wr_ * br - wi_ * bi) : (wr_ * bi + wi_ * br); }
            } else {
#pragma unroll
                for (int e = 0; e < 8; ++e) o[e] = 0.f;
            }
        }
        u32x4 w; w.x = pk2(o[0], o[1]); w.y = pk2(o[2], o[3]); w.z = pk2(o[4], o[5]); w.w = pk2(o[6], o[7]);
        *(u32x4*)((bf16_t*)(ws + WS_BTG) + ((size_t)(g * BT_LD + n) * BT_LD + k0)) = w;
    }
}

typedef short s16x4 __attribute__((ext_vector_type(4)));
__device__ __forceinline__ s16x4 lds_tr16(const LAS unsigned char* p) { return __builtin_bit_cast(s16x4, __builtin_amdgcn_ds_read_tr16_b64_v4i16((LAS s16x4*)p)); }
__device__ __forceinline__ void gmlp_unit(const Args& a, const Ctx& F, int unit) {
    unsigned char* ws = a.ws;
    const int bn = unit / NHEAD, g = unit % NHEAD, row0 = bn * 128;
    const bf16_t* ZG = (const bf16_t*)(ws + WS_ZG);
    constexpr int RS = 272;
    LAS unsigned char* VT = F.lds;
    {
        const int row = F.tid >> 2, q = F.tid & 3;
        const u32x4* src = (const u32x4*)(ZG + (size_t)(row0 + row) * 1536 + GMW + g * 128 + q * 32);
        float v[32]; float s = 0.f;
#pragma unroll
        for (int j = 0; j < 4; ++j) { const u32x4 w = src[j]; v[8 * j + 0] = bf_lo(w.x); v[8 * j + 1] = bf_hi(w.x); v[8 * j + 2] = bf_lo(w.y); v[8 * j + 3] = bf_hi(w.y); v[8 * j + 4] = bf_lo(w.z); v[8 * j + 5] = bf_hi(w.z); v[8 * j + 6] = bf_lo(w.w); v[8 * j + 7] = bf_hi(w.w); }
#pragma unroll
        for (int e = 0; e < 32; ++e) s += v[e];
        s += __shfl_xor(s, 1); s += __shfl_xor(s, 2);
        const float mean = s * (1.f / 128.f); float s2 = 0.f;
#pragma unroll
        for (int e = 0; e < 32; ++e) { v[e] -= mean; s2 += v[e] * v[e]; }
        s2 += __shfl_xor(s2, 1); s2 += __shfl_xor(s2, 2);
        const float rstd = 1.f / sqrtf(s2 * (1.f / 128.f) + LN_EPS);
#pragma unroll
        for (int j = 0; j < 4; ++j) { u32x4 w; w.x = pk2(v[8 * j + 0] * rstd, v[8 * j + 1] * rstd); w.y = pk2(v[8 * j + 2] * rstd, v[8 * j + 3] * rstd); w.z = pk2(v[8 * j + 4] * rstd, v[8 * j + 5] * rstd); w.w = pk2(v[8 * j + 6] * rstd, v[8 * j + 7] * rstd);
            *(LAS u32x4*)(VT + row * RS + q * 64 + j * 16) = w; }
    }
    __syncthreads();
    {
        const int i16 = F.lane & 15, G4 = F.lane >> 4, qtok = F.wave * 16 + i16;
        const bf16_t* wsg = (const bf16_t*)(ws + WS_WSGM) + ((size_t)g * 128 + qtok) * 128 + 8 * G4;
        bf16x8 bfrag[4];
#pragma unroll
        for (int ks = 0; ks < 4; ++ks) bfrag[ks] = *(const bf16x8*)(wsg + 32 * ks);
        const float bs = a.gm_bs[g * 128 + qtok];
        const LAS unsigned char* tb = VT + (8 * G4 + (i16 >> 2)) * RS + (4 * (i16 & 3)) * 2;
        const bf16_t* up = ZG + (size_t)(row0 + qtok) * 1536 + g * 128 + 4 * G4;
        bf16_t* op = (bf16_t*)(ws + WS_AOUT) + (size_t)(row0 + qtok) * D + S5W + g * 128 + 4 * G4;
#pragma unroll 2
        for (int cb = 0; cb < 8; ++cb) {
            f32x4 acc = (f32x4){0.f, 0.f, 0.f, 0.f};
#pragma unroll
            for (int ks = 0; ks < 4; ++ks) {
                const s16x4 lo = lds_tr16(tb + (32 * ks) * RS + cb * 32), hi = lds_tr16(tb + (32 * ks + 4) * RS + cb * 32);
                bf16x8 af; af[0] = lo[0]; af[1] = lo[1]; af[2] = lo[2]; af[3] = lo[3]; af[4] = hi[0]; af[5] = hi[1]; af[6] = hi[2]; af[7] = hi[3];
                acc = __builtin_amdgcn_mfma_f32_16x16x32_bf16(af, bfrag[ks], acc, 0, 0, 0);
            }
            const u32x2 uw = *(const u32x2*)(up + cb * 16);
            u32x2 o; o.x = pk2(bf_lo(uw.x) * (acc[0] + bs), bf_hi(uw.x) * (acc[1] + bs)); o.y = pk2(bf_lo(uw.y) * (acc[2] + bs), bf_hi(uw.y) * (acc[3] + bs));
            *(u32x2*)(op + cb * 16) = o;
        }
    }
    __syncthreads();
}

__device__ __forceinline__ void phase_scan(const Args& a, const Ctx& F) {
    unsigned char* ws = a.ws;
    const int gt = F.vcu * 512 + F.tid;
    if (gt >= NB * 16 * 2 * 64) return;
    const int p = gt & 63, d = (gt >> 6) & 1, g = (gt >> 7) & 15, b = gt >> 11;
    float lr, li, cbr, cbi, tr, ti; s5_param(a, d, g, p, lr, li, cbr, cbi); cpow(lr, li, (float)TCH, tr, ti);
    const float* LOC = (const float*)(ws + WS_LOC) + (size_t)g * AG_ROWS * 256 + d * 128 + p;
    bf16_t* AGs = (bf16_t*)(ws + WS_AG) + (size_t)g * AG_ROWS * AG_LD + 1024 + d * 128 + p;
    float sr = 0.f, si = 0.f;
#pragma unroll
    for (int cc = 0; cc < 4; ++cc) { const int c = d == 0 ? cc : 3 - cc; const float* l = LOC + (size_t)(NCL + b * 4 + c) * 256; const float xr = l[0], xi = l[64];
        const float nr = tr * sr - ti * si + xr, ni = tr * si + ti * sr + xi; sr = nr; si = ni; }
    for (int c0 = 0; c0 < 128; c0 += 16) {
        float xr[16], xi[16];
#pragma unroll
        for (int k = 0; k < 16; ++k) { const int c = d == 0 ? (c0 + k) : (127 - c0 - k); const float* l = LOC + (size_t)(b * 128 + c) * 256; xr[k] = l[0]; xi[k] = l[64]; }
#pragma unroll
        for (int k = 0; k < 16; ++k) { const int c = d == 0 ? (c0 + k) : (127 - c0 - k); bf16_t* o = AGs + (size_t)(b * 128 + c) * AG_LD; o[0] = (bf16_t)f2bf(sr); o[64] = (bf16_t)f2bf(si);
            const float nr = tr * sr - ti * si + xr[k], ni = tr * si + ti * sr + xi[k]; sr = nr; si = ni; }
    }
}

__device__ __forceinline__ void phase_ln1(const Args& a, const Ctx& F) {
    unsigned char* ws = a.ws; const float* mod = (const float*)(ws + WS_MOD);
    LAS float* WR = (LAS float*)F.lds;
    for (int i = F.tid; i < D * NE / 4; i += 512) ((LAS f32x4*)WR)[i] = ((const f32x4*)a.w_router)[i];
    __syncthreads();
    const int gw = F.vcu * NWAVES + F.wave, NGW = F.G * NWAVES;
    for (int m = gw; m < MROWS; m += NGW) {
        const int b = m >> 13, t = m & (SEQ - 1);
        f32x4* yr = (f32x4*)(a.out + (size_t)m * D) + F.lane;
        f32x4 v[4]; float s = 0.f;
#pragma unroll
        for (int j = 0; j < 4; ++j) { v[j] = yr[64 * j]; s += (v[j].x + v[j].y) + (v[j].z + v[j].w); }
        float mean = wave_sum(s) * (1.f / D); float s2 = 0.f;
#pragma unroll
        for (int j = 0; j < 4; ++j) { v[j] = v[j] - mean; s2 += (v[j].x * v[j].x + v[j].y * v[j].y) + (v[j].z * v[j].z + v[j].w * v[j].w); }
        float rstd = 1.f / sqrtf(wave_sum(s2) * (1.f / D) + LN_EPS);
        s = 0.f;
#pragma unroll
        for (int j = 0; j < 4; ++j) { const f32x4 lgj = ((const f32x4*)a.ln1_g)[F.lane + 64 * j], lbj = ((const f32x4*)a.ln1_b)[F.lane + 64 * j]; v[j] = v[j] * rstd * lgj + lbj; yr[64 * j] = v[j]; s += (v[j].x + v[j].y) + (v[j].z + v[j].w); }
        mean = wave_sum(s) * (1.f / D); s2 = 0.f;
#pragma unroll
        for (int j = 0; j < 4; ++j) { v[j] = v[j] - mean; s2 += (v[j].x * v[j].x + v[j].y * v[j].y) + (v[j].z * v[j].z + v[j].w * v[j].w); }
        rstd = 1.f / sqrtf(wave_sum(s2) * (1.f / D) + LN_EPS);
        const float* sh2 = mod + b * 6144 + 3072; const float* sc2 = mod + b * 6144 + 4096;
        unsigned long long* o8 = (unsigned long long*)((bf16_t*)(ws + WS_HBF) + (size_t)m * D) + F.lane;
        float lg16[16];
#pragma unroll
        for (int e = 0; e < 16; ++e) lg16[e] = 0.f;
#pragma unroll
        for (int j = 0; j < 4; ++j) { const f32x4 sv = ((const f32x4*)sh2)[F.lane + 64 * j], cv = ((const f32x4*)sc2)[F.lane + 64 * j]; const f32x4 h = v[j] * rstd * (cv + 1.0f) + sv;
            o8[64 * j] = (unsigned long long)pk2(h.x, h.y) | ((unsigned long long)pk2(h.z, h.w) << 32);
#pragma unroll
            for (int i = 0; i < 4; ++i) { const LAS f32x4* wr4 = (const LAS f32x4*)(WR + (size_t)(4 * F.lane + 256 * j + i) * 16); const float hv = h[i];
#pragma unroll
                for (int q = 0; q < 4; ++q) { const f32x4 w = wr4[q]; lg16[4 * q + 0] += hv * w.x; lg16[4 * q + 1] += hv * w.y; lg16[4 * q + 2] += hv * w.z; lg16[4 * q + 3] += hv * w.w; }
                asm volatile("" ::: "memory"); } }
        float mx = -3.0e38f;
#pragma unroll
        for (int e = 0; e < 16; ++e) { lg16[e] = wave_sum(lg16[e]); mx = fmaxf(mx, lg16[e]); }
        float den = 0.f;
#pragma unroll
        for (int e = 0; e < 16; ++e) { lg16[e] = expf(lg16[e] - mx); den += lg16[e]; }
        const float inv = 1.0f / den; float mine = 0.f;
#pragma unroll
        for (int e = 0; e < 16; ++e) mine = (F.lane == e) ? lg16[e] * inv : mine;
        if (F.lane < 16) ((float*)(ws + WS_AFF))[((size_t)(b * 16 + F.lane)) * SEQ + t] = mine;
    }
}

__device__ __forceinline__ void topk_unit(const Args& a, const Ctx& F, int be) {
    unsigned char* ws = a.ws;
    LAS unsigned* hist = (LAS unsigned*)F.lds;
    LAS unsigned* bc = hist + 256;
    LAS unsigned* wtot = hist + 272;
    const int b = be >> 4, e = be & 15;
    const float* aff = (const float*)(ws + WS_AFF) + (size_t)be * SEQ + F.tid * 16;
    unsigned key[16];
#pragma unroll
    for (int j = 0; j < 4; ++j) { const u32x4 w = ((const u32x4*)aff)[j]; key[4 * j] = w.x; key[4 * j + 1] = w.y; key[4 * j + 2] = w.z; key[4 * j + 3] = w.w; }
    unsigned prefix = 0u, mask = 0u, kk = CAP;
    for (int pass = 0; pass < 4; ++pass) {
        const int shift = 24 - 8 * pass;
        if (F.tid < 256) hist[F.tid] = 0u;
        __syncthreads();
#pragma unroll
        for (int i = 0; i < 16; ++i) if ((key[i] & mask) == prefix) __hip_atomic_fetch_add(&hist[(key[i] >> shift) & 255u], 1u, __ATOMIC_RELAXED, __HIP_MEMORY_SCOPE_WORKGROUP);
        __syncthreads();
        if (F.wave == 0) {
            const unsigned c0 = hist[4 * F.lane], c1 = hist[4 * F.lane + 1], c2 = hist[4 * F.lane + 2], c3 = hist[4 * F.lane + 3];
            unsigned suf = c0 + c1 + c2 + c3;
#pragma unroll
            for (int o = 1; o < 64; o <<= 1) { const unsigned t = __shfl_down(suf, o); suf += (F.lane + o < 64) ? t : 0u; }
            const unsigned above = suf - (c0 + c1 + c2 + c3);
            if (suf >= kk && above < kk) {
                unsigned cum = above, bin, rem;
                if (cum + c3 >= kk) { bin = 3; rem = kk - cum; } else { cum += c3; if (cum + c2 >= kk) { bin = 2; rem = kk - cum; } else { cum += c2; if (cum + c1 >= kk) { bin = 1; rem = kk - cum; } else { cum += c1; bin = 0; rem = kk - cum; } } }
                bc[0] = 4 * F.lane + bin; bc[1] = rem;
            }
        }
        __syncthreads();
        prefix |= bc[0] << shift; mask |= 0xFFu << shift; kk = bc[1];
        __syncthreads();
    }
    unsigned ngt = 0, neq = 0;
#pragma unroll
    for (int i = 0; i < 16; ++i) { ngt += key[i] > prefix ? 1u : 0u; neq += key[i] == prefix ? 1u : 0u; }
    unsigned sg = ngt, se = neq;
#pragma unroll
    for (int o = 1; o < 64; o <<= 1) { const unsigned tg = __shfl_up(sg, o), te = __shfl_up(se, o); if (F.lane >= o) { sg += tg; se += te; } }
    if (F.lane == 63) { wtot[F.wave * 2] = sg; wtot[F.wave * 2 + 1] = se; }
    __syncthreads();
    unsigned gbase = sg - ngt, ebase = se - neq;
    for (int w = 0; w < F.wave; ++w) { gbase += wtot[w * 2]; ebase += wtot[w * 2 + 1]; }
    int* SEL = (int*)(ws + WS_SEL) + be * CAP; float* GATE = (float*)(ws + WS_GATE) + be * CAP; int* INV = (int*)(ws + WS_INV);
#pragma unroll
    for (int i = 0; i < 16; ++i) {
        const int t = F.tid * 16 + i; int slot = -1;
        if (key[i] > prefix) { slot = (int)(gbase + (ebase < kk ? ebase : kk)); ++gbase; }
        else if (key[i] == prefix) { if (ebase < kk) slot = (int)(gbase + ebase); ++ebase; }
        if (slot >= 0) { SEL[slot] = b * SEQ + t; GATE[slot] = __uint_as_float(key[i]); }
        INV[(size_t)(b * SEQ + t) * NE + e] = slot;
    }
    __syncthreads();
}

__device__ __forceinline__ void phase_final(const Args& a, const Ctx& F) {
    unsigned char* ws = a.ws; const float* mod = (const float*)(ws + WS_MOD);
    const int gw = F.vcu * NWAVES + F.wave, NGW = F.G * NWAVES;
    const bf16_t* YEXP = (const bf16_t*)(ws + WS_YEXP); const int* INV = (const int*)(ws + WS_INV);
    for (int m = gw; m < MROWS; m += NGW) {
        const int b = m >> 13;
        f32x4* xr = (f32x4*)(a.out + (size_t)m * D) + F.lane;
        f32x4 mo[4];
#pragma unroll
        for (int j = 0; j < 4; ++j) mo[j] = (f32x4){0.f, 0.f, 0.f, 0.f};
        const int myslot = INV[(size_t)m * NE + (F.lane & 15)];
        for (int e = 0; e < NE; ++e) {
            const int slot = __builtin_amdgcn_readlane(myslot, e);
            if (slot >= 0) { const unsigned long long* yr = (const unsigned long long*)(YEXP + ((size_t)((b * 16 + e) * CAP + slot)) * D) + F.lane;
#pragma unroll
                for (int j = 0; j < 4; ++j) { const unsigned long long w = yr[64 * j]; const unsigned lo = (unsigned)w, hi = (unsigned)(w >> 32); mo[j].x += bf_lo(lo); mo[j].y += bf_hi(lo); mo[j].z += bf_lo(hi); mo[j].w += bf_hi(hi); } }
        }
        const float* g2 = mod + b * 6144 + 5120;
        f32x4 v[4]; float s = 0.f;
#pragma unroll
        for (int j = 0; j < 4; ++j) { const f32x4 gv = ((const f32x4*)g2)[F.lane + 64 * j]; v[j] = xr[64 * j] * ALPHA + gv * mo[j]; s += (v[j].x + v[j].y) + (v[j].z + v[j].w); }
        const float mean = wave_sum(s) * (1.f / D); float s2 = 0.f;
#pragma unroll
        for (int j = 0; j < 4; ++j) { v[j] = v[j] - mean; s2 += (v[j].x * v[j].x + v[j].y * v[j].y) + (v[j].z * v[j].z + v[j].w * v[j].w); }
        const float rstd = 1.f / sqrtf(wave_sum(s2) * (1.f / D) + LN_EPS);
#pragma unroll
        for (int j = 0; j < 4; ++j) { const f32x4 gv = ((const f32x4*)a.ln2_g)[F.lane + 64 * j], bv = ((const f32x4*)a.ln2_b)[F.lane + 64 * j]; xr[64 * j] = v[j] * rstd * gv + bv; }
    }
}

__global__ void __launch_bounds__(NWAVES * 64, 2) dit_fwd(Args args) {
    extern __shared__ __attribute__((aligned(16))) unsigned char lds[];
    Ctx F;
    F.lds = (LAS unsigned char*)lds;
    F.tid = threadIdx.x; F.lane = F.tid & 63; F.wave = __builtin_amdgcn_readfirstlane(F.tid >> 6);
    F.G = gridDim.x; { const int bx = blockIdx.x; F.vcu = (F.G % 8 == 0) ? (bx % 8) * (F.G / 8) + bx / 8 : bx; }
    volatile LAS unsigned* MISC = (volatile LAS unsigned*)(F.lds + MISC_OFF);
    unsigned char* ws = args.ws;
    gu32* ctl = (gu32*)(ws + WS_CTL);
    for (int u = F.tid; u < (LDS_BYTES - LDSCTL_OFF) / 4; u += NWAVES * 64) ((LAS unsigned*)(F.lds + LDSCTL_OFF))[u] = 0u;
    __syncthreads();
    XcdBarrier bar; bar.bar = (unsigned*)(ctl + CW_BAR); bar.x = 0; bar.st = nullptr;
    if (N_LAUNCHES == 1) bar = xcd_barrier_post((unsigned*)(ctl + CW_BAR), MISC + 8);
    const int lo = args.ph_lo, hi = args.ph_hi;
#ifndef PH_MASK
#define PH_MASK 0xFFFFF
#endif
#define IN(k) (((PH_MASK >> (k)) & 1) && lo <= (k) && (k) < hi)
#define SEAM(k) do { if (IN(k) && IN((k) + 1)) xcd_barrier(bar); } while (0)
    const int G = F.G, cb = (int)blockIdx.x;

    if (IN(0)) { phase0(args, F); } SEAM(0);
    if (IN(1)) { phase1(args, F); } SEAM(1);
    if (IN(2)) { PInProj p{(const bf16_t*)(ws + WS_XM), (const bf16_t*)(ws + WS_WINT), (bf16_t*)(ws + WS_AG), (bf16_t*)(ws + WS_ZG), G, cb}; pg8::gemm_phase(F.lds + RING_OFF, p); } SEAM(2);
    if (IN(3)) {
        { PLoc p{(const bf16_t*)(ws + WS_AG), (const bf16_t*)(ws + WS_BTG), (float*)(ws + WS_LOC), G, cb}; pg8::gemm_phase(F.lds + RING_OFF, p); }
        __syncthreads();
        { const int nun = MROWS / 128 * NHEAD; const int heavy = 48 < G ? 48 : 0; const int light = G - heavy;
          if (cb >= heavy) { for (int u = cb - heavy; u < nun - heavy; u += light) gmlp_unit(args, F, u); }
          else gmlp_unit(args, F, nun - heavy + cb); }
    } SEAM(3);
    if (IN(4)) { phase_scan(args, F); } SEAM(4);
    if (IN(5)) { PS5Main p{(const bf16_t*)(ws + WS_AG), (const bf16_t*)(ws + WS_BTG), (bf16_t*)(ws + WS_GY), G, cb}; pg8::gemm_phase(F.lds + RING_OFF, p); } SEAM(5);
    if (IN(6)) { PGlu p{(const bf16_t*)(ws + WS_GY), (const bf16_t*)(ws + WS_WGLUT), args.b_glu, (bf16_t*)(ws + WS_AOUT), G, cb}; pg8::gemm_phase(F.lds + RING_OFF, p); } SEAM(6);
    if (IN(7)) { POutProj p{(const bf16_t*)(ws + WS_AOUT), (const bf16_t*)(ws + WS_WOUTT), args.x, (const float*)(ws + WS_MOD), args.out, G, cb}; pg8::gemm_phase(F.lds + RING_OFF, p); } SEAM(7);
    if (IN(8)) { phase_ln1(args, F); } SEAM(8);
    if (IN(9)) { for (int u = F.vcu; u < NB * NE; u += F.G) topk_unit(args, F, u); } SEAM(9);
    if (IN(10)) { PGateUp p{(const bf16_t*)(ws + WS_HBF), (const bf16_t*)(ws + WS_WGU), (const int*)(ws + WS_SEL), (bf16_t*)(ws + WS_HID), G, cb}; pg8::gemm_phase(F.lds + RING_OFF, p); } SEAM(10);
    if (IN(11)) { PDown p{(const bf16_t*)(ws + WS_HID), (const bf16_t*)(ws + WS_WDN), (const float*)(ws + WS_GATE), (bf16_t*)(ws + WS_YEXP), G, cb}; pg8::gemm_phase(F.lds + RING_OFF, p); } SEAM(11);
    if (IN(12)) { phase_final(args, F); }
#undef IN
#undef SEAM
}

extern "C" void kernel_launch(void* const* d_in, const int* in_sizes, int n_in, void* d_out, int out_size, void* d_ws, size_t ws_size, hipStream_t stream) {
    static int grid = 0;
    if (grid == 0) {
        if (n_in != 28 || in_sizes[0] != MROWS * D || out_size != MROWS * D || ws_size < WS_END) {
            fprintf(stderr, "kernel_launch: built for 28 inputs, x/out of %d floats, >= %zu bytes of workspace; got n_in %d, in0 %d, out %d, ws %zu; nothing launched\n", MROWS * D, (size_t)WS_END, n_in, n_in > 0 ? in_sizes[0] : -1, out_size, ws_size);
            grid = -1; return; }
        int dev = 0, cus = 0, per_cu = 0;
        if (hipGetDevice(&dev) != hipSuccess || hipDeviceGetAttribute(&cus, hipDeviceAttributeMultiprocessorCount, dev) != hipSuccess) { fprintf(stderr, "kernel_launch: device query failed\n"); grid = -1; return; }
        if (hipFuncSetAttribute((const void*)dit_fwd, hipFuncAttributeMaxDynamicSharedMemorySize, LDS_BYTES) != hipSuccess) { fprintf(stderr, "kernel_launch: hipFuncSetAttribute failed\n"); grid = -1; return; }
        if (hipOccupancyMaxActiveBlocksPerMultiprocessor(&per_cu, (const void*)dit_fwd, NWAVES * 64, LDS_BYTES) != hipSuccess || per_cu < 1)
            fprintf(stderr, "kernel_launch: note: occupancy query reports %d workgroups per CU\n", per_cu);
        (void)hipGetLastError();
        grid = cus;
    }
    if (grid < 0) return;
    if (hipMemsetAsync((char*)d_ws + WS_CTL, 0, CTL_ZERO_BYTES, stream) != hipSuccess) { fprintf(stderr, "kernel_launch: hipMemsetAsync failed\n"); return; }
    Args a{};
    const float** ap = (const float**)&a;
    for (int i = 0; i < 28; ++i) ap[i] = (const float*)d_in[i];
    a.out = (float*)d_out; a.ws = (unsigned char*)d_ws;
    for (int li = 0; li < N_LAUNCHES; ++li) {
        a.ph_lo = (N_LAUNCHES == 1) ? 0 : li; a.ph_hi = (N_LAUNCHES == 1) ? NPH : li + 1;
        hipLaunchKernelGGL(dit_fwd, dim3(grid), dim3(NWAVES * 64), LDS_BYTES, stream, a);
        const hipError_t le = hipPeekAtLastError();
        if (le != hipSuccess) { fprintf(stderr, "kernel_launch: launch %d failed: %s\n", li, hipGetErrorName(le)); break; }
    }
}
```

```cpp
#include <hip/hip_runtime.h>
#include <cstdio>
#include <cstdint>

#ifndef MK_N_LAUNCHES
#define MK_N_LAUNCHES 1
#endif

namespace pg8 {
#define PG8_LAS __attribute__((address_space(3)))
typedef unsigned short bf16_t;
typedef short bf16x8 __attribute__((ext_vector_type(8)));
typedef float f32x4 __attribute__((ext_vector_type(4)));
typedef float f32x2 __attribute__((ext_vector_type(2)));
typedef unsigned u32x4 __attribute__((ext_vector_type(4)));
typedef unsigned u32x2 __attribute__((ext_vector_type(2)));
constexpr int BM = 256, BK = 64, HALF = 128, HTB = HALF * BK * 2  , STAGE_BYTES = 8 * HTB, NXCD = 8, WGM = 8;

__host__ __device__ __forceinline__ int lds_byte(int r, int c) { const int st = (r >> 4) * 2 + (c >> 5), rr = r & 15, cc = c & 31, ob = rr * 64 + cc * 2; return st * 1024 + (ob ^ (((ob >> 9) & 1) << 5)); }
__host__ __device__ __forceinline__ void stage_rc(int b, int& R, int& C) { const int st = b / 1024, sb = b % 1024, swz = sb ^ (((sb >> 9) & 1) << 5); R = (st >> 1) * 16 + swz / 64; C = (st & 1) * 32 + (swz % 64) / 2; }
__host__ __device__ __forceinline__ int perm32(int rho) { const int n = rho >> 4, i = rho & 15; return 8 * (i >> 2) + 4 * n + (i & 3); }

struct Unit { int pm, pn, z; };

__device__ __forceinline__ void tile_order(int L, int nM, int nN, int& pm, int& pn) {
    const int nwg = nM * nN; int wgid = L;
    { const int q = nwg / NXCD, r = nwg % NXCD, xcd = wgid % NXCD, off = wgid / NXCD; wgid = (xcd < r ? xcd * (q + 1) : r * (q + 1) + (xcd - r) * q) + off; }
    const int nig = WGM * nN, gid = wgid / nig, fm = gid * WGM, gsz = (nM - fm) < WGM ? (nM - fm) : WGM;
    pm = fm + ((wgid % nig) % gsz); pn = (wgid % nig) / gsz;
}

__device__ __forceinline__ unsigned cvt_pk_bf16(float lo, float hi) { unsigned r; asm volatile("v_cvt_pk_bf16_f32 %0, %1, %2" : "=v"(r) : "v"(lo), "v"(hi)); return r; }
__device__ __forceinline__ float bf_lo(unsigned w) { return __uint_as_float(w << 16); }
__device__ __forceinline__ float bf_hi(unsigned w) { return __uint_as_float(w & 0xffff0000u); }
__device__ __forceinline__ float fast_sigmoid(float x) { return __builtin_amdgcn_rcpf(1.0f + __builtin_amdgcn_exp2f(-1.44269504f * x)); }
__device__ __forceinline__ float gelu_tanh(float x) { const float u = x * (1.0f + 0.044715f * x * x) * 1.5957691216f; return x * fast_sigmoid(u); }

template <class P>
__device__ __forceinline__ void gemm_phase(PG8_LAS unsigned char* lds, const P& p) {
    const int tid = threadIdx.x, wid = __builtin_amdgcn_readfirstlane(tid >> 6), lane = tid & 63, wr = wid >> 2, wc = wid & 3, fr = lane & 15, fq = lane >> 4;
    constexpr int K = P::K, nt = K / BK, lda = P::LDA, ldb = P::LDB;
    static_assert(K % 128 == 0 && K >= 256, "K multiple of 128, >= 256");
    int Rr[2], Cc[2]; unsigned voB[2];
#pragma unroll
    for (int i = 0; i < 2; ++i) { int R, C; stage_rc(tid * 16 + i * 8192, R, C); Rr[i] = R; Cc[i] = C; const int Rb = P::PERM ? ((R & ~31) + perm32(R & 31)) : R; voB[i] = (unsigned)(Rb * ldb + C) * 2u; }
    unsigned voA[2][2], nvoA[2][2];
#define PG8_SETVOA(v, u) do { _Pragma("unroll") for (int _h = 0; _h < 2; ++_h) _Pragma("unroll") for (int _i = 0; _i < 2; ++_i) { const int _r = _h * HALF + Rr[_i]; \
        unsigned _row; if constexpr (P::GATHER) _row = (unsigned)p.a_row(u, _r); else _row = (unsigned)_r; v[_h][_i] = (_row * (unsigned)lda + (unsigned)Cc[_i]) * 2u; } } while (0)
    const size_t kstep = (size_t)(BK * 2);
    const size_t hstepB = (size_t)HALF * ldb * 2;
    const unsigned ldsw = (unsigned)wid * 1024u;
    const int aoff = lds_byte(wr * 64 + fr, fq * 8), boff = lds_byte(wc * 32 + fr, fq * 8);
#define PG8_SA(b, h) (((b) * 2 + (h)) * HTB)
#define PG8_SB(b, h) ((4 + (b) * 2 + (h)) * HTB)
#define PG8_STAGE(bufoff, gbase, v0, v1) do { \
        __builtin_amdgcn_global_load_lds((const unsigned*)((const char*)(gbase) + (v0)), (PG8_LAS unsigned*)(lds + (bufoff) + ldsw), 16, 0, 0); \
        __builtin_amdgcn_global_load_lds((const unsigned*)((const char*)(gbase) + (v1)), (PG8_LAS unsigned*)(lds + (bufoff) + ldsw + 8192), 16, 0, 0); } while (0)
#define PG8_STAGE_A(bufoff, gbase, V, h) PG8_STAGE(bufoff, gbase, V[h][0], V[h][1])
#define PG8_STAGE_B(bufoff, gbase) PG8_STAGE(bufoff, gbase, voB[0], voB[1])
#define PG8_LDA(dst, b, h) do { _Pragma("unroll") for (int m = 0; m < 4; ++m) _Pragma("unroll") for (int k = 0; k < 2; ++k) dst[m][k] = *(const PG8_LAS bf16x8*)(lds + PG8_SA(b, h) + aoff + m * 2048 + k * 1024); } while (0)
#define PG8_LDB(dst, b, h) do { _Pragma("unroll") for (int n = 0; n < 2; ++n) _Pragma("unroll") for (int k = 0; k < 2; ++k) dst[n][k] = *(const PG8_LAS bf16x8*)(lds + PG8_SB(b, h) + boff + n * 2048 + k * 1024); } while (0)
#define PG8_MMA(ai, bj, At, Bt) do { __builtin_amdgcn_s_setprio(1); _Pragma("unroll") for (int m = 0; m < 4; ++m) _Pragma("unroll") for (int n = 0; n < 2; ++n) _Pragma("unroll") for (int k = 0; k < 2; ++k) \
        acc[ai][bj][m][n] = __builtin_amdgcn_mfma_f32_16x16x32_bf16(Bt[n][k], At[m][k], acc[ai][bj][m][n], 0, 0, 0); __builtin_amdgcn_s_setprio(0); } while (0)
#define PG8_WAIT_V(n) asm volatile("s_waitcnt vmcnt(" #n ")" ::: "memory")
#define PG8_WAIT_L(n) asm volatile("s_waitcnt lgkmcnt(" #n ")" ::: "memory")
#define PG8_BAR __builtin_amdgcn_s_barrier()
#define PG8_SCHED __builtin_amdgcn_sched_barrier(0)
    Unit cur, nxt; int ui = 0;
    if (!p.next(0, cur)) return;
    f32x4 acc[2][2][4][2];
#pragma unroll
    for (int a = 0; a < 2; ++a)
#pragma unroll
        for (int b = 0; b < 2; ++b)
#pragma unroll
            for (int m = 0; m < 4; ++m)
#pragma unroll
                for (int n = 0; n < 2; ++n) acc[a][b][m][n] = (f32x4){0.f, 0.f, 0.f, 0.f};
    bf16x8 At[4][2], B0[2][2], B1[2][2];
    const char* cA = (const char*)p.a_base(cur); const char* cB = (const char*)p.b_base(cur);
    PG8_SETVOA(voA, cur);
    PG8_STAGE_B(PG8_SB(0, 0), cB); PG8_STAGE_B(PG8_SB(0, 1), cB + hstepB); PG8_STAGE_A(PG8_SA(0, 0), cA, voA, 0); PG8_STAGE_A(PG8_SA(0, 1), cA, voA, 1);
    if (wr == 1) PG8_BAR;
    PG8_WAIT_V(2); PG8_BAR;
    PG8_STAGE_B(PG8_SB(1, 0), cB + kstep); PG8_STAGE_A(PG8_SA(1, 0), cA + kstep, voA, 0); PG8_STAGE_B(PG8_SB(1, 1), cB + hstepB + kstep);
    PG8_WAIT_V(6); PG8_BAR;
    for (;;) {
        const bool has_next = p.next(ui + 1, nxt);
        const char* nA = has_next ? (const char*)p.a_base(nxt) : cA; const char* nB = has_next ? (const char*)p.b_base(nxt) : cB;
        if constexpr (P::GATHER) {
            if (has_next) PG8_SETVOA(nvoA, nxt);
            else {
#pragma unroll
                for (int h = 0; h < 2; ++h)
#pragma unroll
                    for (int i = 0; i < 2; ++i) nvoA[h][i] = voA[h][i]; }
        }
#pragma nounroll
        for (int t = 0; t < nt; t += 2) {
            const bool last = (t == nt - 2);
            const char* a1 = cA + (size_t)(t + 1) * kstep;
            const char* a2 = last ? nA : cA + (size_t)(t + 2) * kstep; const char* b2 = last ? nB : cB + (size_t)(t + 2) * kstep;
            const char* a3 = a2 + kstep; const char* b3 = b2 + kstep;
            unsigned wA[2][2];
#pragma unroll
            for (int h = 0; h < 2; ++h)
#pragma unroll
                for (int i = 0; i < 2; ++i) { if constexpr (P::GATHER) wA[h][i] = last ? nvoA[h][i] : voA[h][i]; else wA[h][i] = voA[h][i]; }
            PG8_LDB(B0, 0, 0); PG8_LDB(B1, 0, 1); PG8_SCHED; PG8_LDA(At, 0, 0); PG8_STAGE_A(PG8_SA(1, 1), a1, voA, 1);
            PG8_WAIT_V(8); PG8_WAIT_L(0); PG8_BAR; PG8_MMA(0, 0, At, B0); PG8_MMA(0, 1, At, B1); PG8_BAR; PG8_SCHED;
            PG8_LDA(At, 0, 1); PG8_STAGE_B(PG8_SB(0, 0), b2); PG8_STAGE_B(PG8_SB(0, 1), b2 + hstepB); PG8_STAGE_A(PG8_SA(0, 0), a2, wA, 0);
            PG8_WAIT_V(8); PG8_WAIT_L(0); PG8_BAR; PG8_MMA(1, 0, At, B0); PG8_MMA(1, 1, At, B1); PG8_BAR; PG8_SCHED;
            PG8_LDB(B0, 1, 0); PG8_LDB(B1, 1, 1); PG8_SCHED; PG8_LDA(At, 1, 0); PG8_STAGE_A(PG8_SA(0, 1), a2, wA, 1);
            PG8_WAIT_V(8); PG8_WAIT_L(0); PG8_BAR; PG8_MMA(0, 0, At, B0); PG8_MMA(0, 1, At, B1); PG8_BAR; PG8_SCHED;
            PG8_LDA(At, 1, 1); PG8_STAGE_B(PG8_SB(1, 0), b3); PG8_STAGE_B(PG8_SB(1, 1), b3 + hstepB); PG8_STAGE_A(PG8_SA(1, 0), a3, wA, 0);
            PG8_WAIT_V(8); PG8_WAIT_L(0); PG8_BAR; PG8_MMA(1, 0, At, B0); PG8_MMA(1, 1, At, B1); PG8_BAR; PG8_SCHED;
        }
        if (wr == 0) PG8_BAR;
        p.epi(acc, cur, wr, wc, fr, fq);
        if (!has_next) break;
#pragma unroll
        for (int a = 0; a < 2; ++a)
#pragma unroll
            for (int b = 0; b < 2; ++b)
#pragma unroll
                for (int m = 0; m < 4; ++m)
#pragma unroll
                    for (int n = 0; n < 2; ++n) acc[a][b][m][n] = (f32x4){0.f, 0.f, 0.f, 0.f};
        cur = nxt; cA = nA; cB = nB; ++ui;
        if constexpr (P::GATHER) {
#pragma unroll
            for (int h = 0; h < 2; ++h)
#pragma unroll
                for (int i = 0; i < 2; ++i) voA[h][i] = nvoA[h][i]; }
        if (wr == 1) PG8_BAR;
    }
    PG8_WAIT_V(0);
    PG8_BAR;
#undef PG8_SETVOA
#undef PG8_SA
#undef PG8_SB
#undef PG8_STAGE
#undef PG8_STAGE_A
#undef PG8_STAGE_B
#undef PG8_LDA
#undef PG8_LDB
#undef PG8_MMA
#undef PG8_WAIT_V
#undef PG8_WAIT_L
#undef PG8_BAR
#undef PG8_SCHED
}
}
using pg8::bf16_t; using pg8::f32x4; using pg8::f32x2; using pg8::u32x4; using pg8::u32x2; using pg8::bf16x8; using pg8::Unit;
using pg8::cvt_pk_bf16; using pg8::bf_lo; using pg8::bf_hi; using pg8::gelu_tanh; using pg8::fast_sigmoid;

constexpr int NWAVES = 8;
constexpr int D = 1024, NB = 4, SEQ = 8192, CTXL = 256;
constexpr int MROWS = NB * SEQ, CROWS = NB * CTXL, XROWS = MROWS + CROWS;
constexpr int S5W = 256, GMW = 768, INC = 1792, NE = 16, CAP = 1024, DFF = 2816, NHEAD = 6;
constexpr int TCH = 64, NCL = MROWS / TCH, NCC = CROWS / TCH;
constexpr int AG_ROWS = 768, AG_LD = 1280, BT_LD = 1280;
constexpr float ALPHA = 1.189207115f;
constexpr float LN_EPS = 1e-6f;
constexpr int NPH = 13;
constexpr int N_LAUNCHES = MK_N_LAUNCHES;
static_assert(N_LAUNCHES == 1 || N_LAUNCHES == NPH, "MK_N_LAUNCHES is 1 or NPH");

constexpr size_t MiB = 1u << 20;
constexpr size_t WS_CTL = 0, CTL_ZERO_BYTES = 64 * 1024;
constexpr size_t WS_MOD = 1 * MiB;
constexpr size_t WS_PAR = 1 * MiB + 256 * 1024;
constexpr size_t WS_WINT = 2 * MiB;
constexpr size_t WS_WOUTT = 6 * MiB;
constexpr size_t WS_WGLUT = 8 * MiB;
constexpr size_t WS_WSGM = 8 * MiB + 256 * 1024;
constexpr size_t WS_SEL = 9 * MiB;
constexpr size_t WS_GATE = 9 * MiB + 512 * 1024;
constexpr size_t WS_AFF = 10 * MiB;
constexpr size_t WS_INV = 12 * MiB;
constexpr size_t WS_KTAB = 14 * MiB;
constexpr size_t WS_HBF = 16 * MiB;
constexpr size_t WS_WGU = 80 * MiB;
constexpr size_t WS_YEXP = WS_WGU;
constexpr size_t WS_WDN = 256 * MiB;
constexpr size_t WS_BIG = 344 * MiB;
constexpr size_t WS_HID = WS_BIG;
constexpr size_t WS_XM = WS_BIG;
constexpr size_t WS_ZG = WS_BIG + 66 * MiB;
constexpr size_t WS_AG = WS_BIG + 162 * MiB;
constexpr size_t WS_BTG = WS_BIG + 192 * MiB;
constexpr size_t WS_LOC = WS_BIG + 242 * MiB;
constexpr size_t WS_GY = WS_BIG + 254 * MiB;
constexpr size_t WS_AOUT = WS_BIG + 270 * MiB;
constexpr size_t WS_END = WS_BIG + 352 * MiB;
static_assert(WS_AOUT + 64 * MiB <= WS_END, "temporaries inside the HID overlay");
constexpr int CW_BAR = 1024;

constexpr int RING_OFF = 0, RING_BYTES = 131072;
constexpr int LDSCTL_OFF = RING_BYTES, MISC_OFF = LDSCTL_OFF + 320;
constexpr int LDS_BYTES = 147456;

#define GAS __attribute__((address_space(1)))
#define LAS __attribute__((address_space(3)))
typedef GAS unsigned gu32;
#define RLX_AGENT __ATOMIC_RELAXED, __HIP_MEMORY_SCOPE_AGENT
#define LDS_WAIT() asm volatile("s_waitcnt lgkmcnt(0)" ::: "memory")
__device__ __forceinline__ unsigned f2bf(float f) { unsigned u = __builtin_bit_cast(unsigned, f); return (u + 0x7fffu + ((u >> 16) & 1u)) >> 16; }
__device__ __forceinline__ unsigned pk2(float lo, float hi) { return f2bf(lo) | (f2bf(hi) << 16); }
__device__ __forceinline__ float wave_sum(float v) {
#pragma unroll
    for (int o = 1; o < 64; o <<= 1) v += __shfl_xor(v, o);
    return v;
}

#define XB_TMO      128
#define XB_XCNT(j)  (256  + 64 * (j))
#define XB_XSUB(j)  (1280 + 64 * (j))
#define XB_XGEN(j)  (2304 + 64 * (j))
#define XB_TOP      3328
#define XB_TOPGEN   3392
#define XCD_BAR_WORDS 3456
#define XB_SPIN_CAP (1u << 18)
__device__ __forceinline__ unsigned xb_ld(unsigned* p)              { return __hip_atomic_load(p, __ATOMIC_RELAXED, __HIP_MEMORY_SCOPE_AGENT); }
__device__ __forceinline__ unsigned xb_add(unsigned* p, unsigned v) { return __hip_atomic_fetch_add(p, v, __ATOMIC_RELAXED, __HIP_MEMORY_SCOPE_AGENT); }
__device__ __forceinline__ unsigned xb_xcc_id() { return (unsigned)__builtin_amdgcn_s_getreg((3 << 11) | 20) & 0xFu; }
#define XB_SPIN(cond, bar) do { unsigned _sp = 0; while (cond) { __builtin_amdgcn_s_sleep(1); \
    if ((++_sp & 255u) == 0u) { if (xb_ld(&(bar)[XB_TMO])) break; if (_sp > XB_SPIN_CAP) { atomicAdd(&(bar)[XB_TMO], 1u); break; } } } } while (0)
struct XcdBarrier { unsigned* bar; unsigned x; volatile LAS unsigned* st; };
__device__ __forceinline__ XcdBarrier xcd_barrier_post(unsigned* bar, volatile LAS unsigned* st) {
    XcdBarrier b; b.bar = bar; b.x = xb_xcc_id(); b.st = st;
    if (threadIdx.x == 0) (void)xb_add(&bar[XB_XCNT(b.x)], 1u);
    return b;
}
__device__ __forceinline__ void xcd_barrier_complete(unsigned* bar, unsigned x, unsigned& nloc, unsigned& nx) {
    const unsigned G = gridDim.x * gridDim.y * gridDim.z;
    unsigned sum, cnt, mine, sp = 0u;
    for (;;) {
        sum = 0u; cnt = 0u; mine = 0u;
#pragma unroll
        for (unsigned j = 0; j < 16; ++j) { const unsigned c = xb_ld(&bar[XB_XCNT(j)]); sum += c; cnt += (c > 0u) ? 1u : 0u; mine = (j == x) ? c : mine; }
        if (sum == G) break;
        __builtin_amdgcn_s_sleep(1);
        if ((++sp & 255u) == 0u) { if (xb_ld(&bar[XB_TMO])) break; if (sp > XB_SPIN_CAP) { atomicAdd(&bar[XB_TMO], 1u); break; } }
    }
    nloc = mine > 0u ? mine : 1u; nx = cnt > 0u ? cnt : 1u;
}
__device__ __forceinline__ void xcd_barrier(const XcdBarrier& b) {
    asm volatile("s_waitcnt vmcnt(0)" ::: "memory");
    __syncthreads();
    if (threadIdx.x == 0) {
        unsigned* bar = b.bar;
        __builtin_amdgcn_s_waitcnt(0);
        unsigned nloc = b.st[0], nx = b.st[1];
        if (nloc == 0u) { xcd_barrier_complete(bar, b.x, nloc, nx); b.st[0] = nloc; b.st[1] = nx; }
        const unsigned old = xb_add(&bar[XB_XSUB(b.x)], 1u);
        const unsigned gen = old / nloc;
        if (old + 1u == (gen + 1u) * nloc) {
            __builtin_amdgcn_fence(__ATOMIC_RELEASE, "agent");
            asm volatile("s_waitcnt vmcnt(0)" ::: "memory");
            const unsigned og = xb_add(&bar[XB_TOP], 1u);
            const unsigned tg = og / nx;
            if (og + 1u == (tg + 1u) * nx) xb_add(&bar[XB_TOPGEN], 1u);
            else XB_SPIN(xb_ld(&bar[XB_TOPGEN]) == tg, bar);
            __builtin_amdgcn_fence(__ATOMIC_ACQUIRE, "agent");
            xb_add(&bar[XB_XGEN(b.x)], 1u);
            asm volatile("s_waitcnt vmcnt(0)" ::: "memory");
        } else {
            XB_SPIN(xb_ld(&bar[XB_XGEN(b.x)]) == gen, bar);
            __builtin_amdgcn_fence(__ATOMIC_ACQUIRE, "agent");
            asm volatile("s_waitcnt vmcnt(0)" ::: "memory");
        }
    }
    __syncthreads();
}

struct Args {
    const float *x, *c, *ctx, *c_ctx, *w_ada, *b_ada, *w_in, *gm_ws, *gm_bs, *a_re, *a_im, *log_step, *b_re, *b_im, *c_re, *c_im, *s5_d, *w_glu, *b_glu, *w_out,
                *ln1_g, *ln1_b, *w_router, *w_gate, *w_up, *w_down, *ln2_g, *ln2_b;
    float* out; unsigned char* ws; int ph_lo, ph_hi;
};

struct PInProj {
    static constexpr bool PERM = true, GATHER = false; static constexpr int K = D, LDA = D, LDB = D;
    const bf16_t* A; const bf16_t* Bt; bf16_t* AG; bf16_t* ZG; int G, c;
    __device__ __forceinline__ bool next(int i, Unit& u) const { const int L = i * G + c; if (L >= 900) return false; if (L < 4) { u.pm = 128 + L; u.pn = 0; } else pg8::tile_order(L - 4, 128, 7, u.pm, u.pn); u.z = 0; return true; }
    __device__ __forceinline__ const bf16_t* a_base(const Unit& u) const { return A + (size_t)u.pm * 256 * D; }
    __device__ __forceinline__ const bf16_t* b_base(const Unit& u) const { return Bt + (size_t)u.pn * 256 * D; }
    __device__ __forceinline__ int a_row(const Unit&, int r) const { return r; }
    __device__ __forceinline__ void epi(const f32x4 (&acc)[2][2][4][2], const Unit& u, int wr, int wc, int fr, int fq) const {
        const int row0 = u.pm * 256 + wr * 64 + fr;
        if (u.pn == 0) {
#pragma unroll
            for (int ai = 0; ai < 2; ++ai)
#pragma unroll
                for (int m = 0; m < 4; ++m) { const int row = row0 + ai * 128 + m * 16; const int chunk = row < MROWS ? (row >> 6) : (NCL + ((row - MROWS) >> 6)); const int ti = row & 63;
#pragma unroll
                    for (int bj = 0; bj < 2; ++bj) { const int c0 = bj * 128 + wc * 32 + 8 * fq, g = c0 >> 4, h0 = c0 & 15; const f32x4 v0 = acc[ai][bj][m][0], v1 = acc[ai][bj][m][1];
                        u32x4 w; w.x = cvt_pk_bf16(v0[0], v0[1]); w.y = cvt_pk_bf16(v0[2], v0[3]); w.z = cvt_pk_bf16(v1[0], v1[1]); w.w = cvt_pk_bf16(v1[2], v1[3]);
                        *(u32x4*)(AG + ((size_t)(g * AG_ROWS + chunk) * AG_LD + ti * 16 + h0)) = w; } }
        } else {
            const int col0 = (u.pn - 1) * 256 + wc * 32 + 8 * fq;
#pragma unroll
            for (int ai = 0; ai < 2; ++ai)
#pragma unroll
                for (int m = 0; m < 4; ++m) { bf16_t* rowp = ZG + (size_t)(row0 + ai * 128 + m * 16) * 1536 + col0;
#pragma unroll
                    for (int bj = 0; bj < 2; ++bj) { const f32x4 v0 = acc[ai][bj][m][0], v1 = acc[ai][bj][m][1];
                        u32x4 w; w.x = cvt_pk_bf16(gelu_tanh(v0[0]), gelu_tanh(v0[1])); w.y = cvt_pk_bf16(gelu_tanh(v0[2]), gelu_tanh(v0[3]));
                        w.z = cvt_pk_bf16(gelu_tanh(v1[0]), gelu_tanh(v1[1])); w.w = cvt_pk_bf16(gelu_tanh(v1[2]), gelu_tanh(v1[3]));
                        *(u32x4*)(rowp + bj * 128) = w; } }
        }
    }
};
struct PLoc {
    static constexpr bool PERM = false, GATHER = false; static constexpr int K = 1024, LDA = AG_LD, LDB = BT_LD;
    const bf16_t* AG; const bf16_t* BTG; float* LOC; int G, c;
    __device__ __forceinline__ bool next(int i, Unit& u) const { const int L = i * G + c; if (L >= 48) return false; u.z = L / 3; u.pm = L % 3; u.pn = 0; return true; }
    __device__ __forceinline__ const bf16_t* a_base(const Unit& u) const { return AG + (size_t)(u.z * AG_ROWS + u.pm * 256) * AG_LD; }
    __device__ __forceinline__ const bf16_t* b_base(const Unit& u) const { return BTG + (size_t)(u.z * BT_LD + 1024) * BT_LD; }
    __device__ __forceinline__ int a_row(const Unit&, int r) const { return r; }
    __device__ __forceinline__ void epi(const f32x4 (&acc)[2][2][4][2], const Unit& u, int wr, int wc, int fr, int fq) const {
        const int row0 = u.pm * 256 + wr * 64 + fr, col0 = wc * 32 + 4 * fq;
#pragma unroll
        for (int ai = 0; ai < 2; ++ai)
#pragma unroll
            for (int m = 0; m < 4; ++m) { float* rowp = LOC + (size_t)(u.z * AG_ROWS + row0 + ai * 128 + m * 16) * 256 + col0;
#pragma unroll
                for (int bj = 0; bj < 2; ++bj)
#pragma unroll
                    for (int n = 0; n < 2; ++n) *(f32x4*)(rowp + bj * 128 + n * 16) = acc[ai][bj][m][n]; }
    }
};
struct PS5Main {
    static constexpr bool PERM = true, GATHER = false; static constexpr int K = 1280, LDA = AG_LD, LDB = BT_LD;
    const bf16_t* AG; const bf16_t* BTG; bf16_t* GY; int G, c;
    __device__ __forceinline__ bool next(int i, Unit& u) const { const int L = i * G + c; if (L >= 128) return false; u.z = L >> 3; u.pm = (L >> 2) & 1; u.pn = L & 3; return true; }
    __device__ __forceinline__ const bf16_t* a_base(const Unit& u) const { return AG + (size_t)(u.z * AG_ROWS + u.pm * 256) * AG_LD; }
    __device__ __forceinline__ const bf16_t* b_base(const Unit& u) const { return BTG + (size_t)(u.z * BT_LD + u.pn * 256) * BT_LD; }
    __device__ __forceinline__ int a_row(const Unit&, int r) const { return r; }
    __device__ __forceinline__ void epi(const f32x4 (&acc)[2][2][4][2], const Unit& u, int wr, int wc, int fr, int fq) const {
        const int chunk0 = u.pm * 256 + wr * 64 + fr;
#pragma unroll
        for (int ai = 0; ai < 2; ++ai)
#pragma unroll
            for (int m = 0; m < 4; ++m) { const int chunk = chunk0 + ai * 128 + m * 16;
#pragma unroll
                for (int bj = 0; bj < 2; ++bj) { const int n0 = u.pn * 256 + bj * 128 + wc * 32 + 8 * fq, j = n0 >> 4, h0 = n0 & 15; const f32x4 v0 = acc[ai][bj][m][0], v1 = acc[ai][bj][m][1];
                    u32x4 w; w.x = cvt_pk_bf16(gelu_tanh(v0[0]), gelu_tanh(v0[1])); w.y = cvt_pk_bf16(gelu_tanh(v0[2]), gelu_tanh(v0[3]));
                    w.z = cvt_pk_bf16(gelu_tanh(v1[0]), gelu_tanh(v1[1])); w.w = cvt_pk_bf16(gelu_tanh(v1[2]), gelu_tanh(v1[3]));
                    *(u32x4*)(GY + ((size_t)(chunk * TCH + j) * S5W + u.z * 16 + h0)) = w; } }
    }
};
struct PGlu {
    static constexpr bool PERM = true, GATHER = false; static constexpr int K = 256, LDA = 256, LDB = 256;
    const bf16_t* GY; const bf16_t* Bt; const float* b_glu; bf16_t* AOUT; int G, c;
    __device__ __forceinline__ bool next(int i, Unit& u) const { const int L = i * G + c; if (L >= 128) return false; u.pm = L; u.pn = 0; u.z = 0; return true; }
    __device__ __forceinline__ const bf16_t* a_base(const Unit& u) const { return GY + (size_t)u.pm * 256 * 256; }
    __device__ __forceinline__ const bf16_t* b_base(const Unit&) const { return Bt; }
    __device__ __forceinline__ int a_row(const Unit&, int r) const { return r; }
    __device__ __forceinline__ void epi(const f32x4 (&acc)[2][2][4][2], const Unit& u, int wr, int wc, int fr, int fq) const {
        const int row0 = u.pm * 256 + wr * 64 + fr, col0 = wc * 32 + 8 * fq;
        f32x4 bv[2][2];
#pragma unroll
        for (int bj = 0; bj < 2; ++bj)
#pragma unroll
            for (int n = 0; n < 2; ++n) bv[bj][n] = *(const f32x4*)(b_glu + col0 + bj * 128 + 4 * n);
#pragma unroll
        for (int ai = 0; ai < 2; ++ai)
#pragma unroll
            for (int m = 0; m < 4; ++m) { const int row = row0 + ai * 128 + m * 16;
#pragma unroll
                for (int bj = 0; bj < 2; ++bj) { const u32x4 gw = *(const u32x4*)(GY + (size_t)row * 256 + col0 + bj * 128);
                    const f32x4 v0 = acc[ai][bj][m][0] + bv[bj][0], v1 = acc[ai][bj][m][1] + bv[bj][1];
                    u32x4 w; w.x = cvt_pk_bf16(bf_lo(gw.x) * fast_sigmoid(v0[0]), bf_hi(gw.x) * fast_sigmoid(v0[1])); w.y = cvt_pk_bf16(bf_lo(gw.y) * fast_sigmoid(v0[2]), bf_hi(gw.y) * fast_sigmoid(v0[3]));
                    w.z = cvt_pk_bf16(bf_lo(gw.z) * fast_sigmoid(v1[0]), bf_hi(gw.z) * fast_sigmoid(v1[1])); w.w = cvt_pk_bf16(bf_lo(gw.w) * fast_sigmoid(v1[2]), bf_hi(gw.w) * fast_sigmoid(v1[3]));
                    *(u32x4*)(AOUT + (size_t)row * D + col0 + bj * 128) = w; }
                asm volatile("" ::: "memory"); }
    }
};
struct POutProj {
    static constexpr bool PERM = false, GATHER = false; static constexpr int K = D, LDA = D, LDB = D;
    const bf16_t* A; const bf16_t* Bt; const float* x; const float* mod; float* Y; int G, c;
    __device__ __forceinline__ bool next(int i, Unit& u) const { const int L = i * G + c; if (L >= 512) return false; pg8::tile_order(L, 128, 4, u.pm, u.pn); u.z = 0; return true; }
    __device__ __forceinline__ const bf16_t* a_base(const Unit& u) const { return A + (size_t)u.pm * 256 * D; }
    __device__ __forceinline__ const bf16_t* b_base(const Unit& u) const { return Bt + (size_t)u.pn * 256 * D; }
    __device__ __forceinline__ int a_row(const Unit&, int r) const { return r; }
    __device__ __forceinline__ void epi(const f32x4 (&acc)[2][2][4][2], const Unit& u, int wr, int wc, int fr, int fq) const {
        const int row0 = u.pm * 256 + wr * 64 + fr, col0 = u.pn * 256 + wc * 32 + 4 * fq;
        const float* g1 = mod + (size_t)(u.pm >> 5) * 6144 + 2048;
        f32x4 gv[2][2];
#pragma unroll
        for (int bj = 0; bj < 2; ++bj)
#pragma unroll
            for (int n = 0; n < 2; ++n) gv[bj][n] = *(const f32x4*)(g1 + col0 + bj * 128 + n * 16);
#pragma unroll
        for (int ai = 0; ai < 2; ++ai)
#pragma unroll
            for (int m = 0; m < 4; ++m) { const size_t off = (size_t)(row0 + ai * 128 + m * 16) * D + col0;
#pragma unroll
                for (int bj = 0; bj < 2; ++bj)
#pragma unroll
                    for (int n = 0; n < 2; ++n) { const f32x4 xv = *(const f32x4*)(x + off + bj * 128 + n * 16); *(f32x4*)(Y + off + bj * 128 + n * 16) = xv * ALPHA + gv[bj][n] * acc[ai][bj][m][n]; }
                asm volatile("" ::: "memory"); }
    }
};
__device__ __forceinline__ void moe_tile(int pmx, int& e, int& rowbase) { e = pmx >> 4; const int b = (pmx >> 2) & 3, mt = pmx & 3; rowbase = (b * 16 + e) * CAP + mt * 256; }
struct PGateUp {
    static constexpr bool PERM = true, GATHER = true; static constexpr int K = D, LDA = D, LDB = D;
    const bf16_t* HBF; const bf16_t* WGU; const int* SEL; bf16_t* HID; int G, c;
    __device__ __forceinline__ bool next(int i, Unit& u) const { const int L = i * G + c; if (L >= 256 * 22) return false; pg8::tile_order(L, 256, 22, u.pm, u.pn); int e, rb; moe_tile(u.pm, e, rb); u.z = rb; return true; }
    __device__ __forceinline__ const bf16_t* a_base(const Unit&) const { return HBF; }
    __device__ __forceinline__ const bf16_t* b_base(const Unit& u) const { return WGU + ((size_t)(u.pm >> 4) * 5632 + (size_t)u.pn * 256) * D; }
    __device__ __forceinline__ int a_row(const Unit& u, int r) const { return SEL[u.z + r]; }
    __device__ __forceinline__ void epi(const f32x4 (&acc)[2][2][4][2], const Unit& u, int wr, int wc, int fr, int fq) const {
        const int row0 = u.z + wr * 64 + fr, col0 = u.pn * 128 + wc * 32 + 8 * fq;
#pragma unroll
        for (int ai = 0; ai < 2; ++ai)
#pragma unroll
            for (int m = 0; m < 4; ++m) { bf16_t* rowp = HID + (size_t)(row0 + ai * 128 + m * 16) * DFF + col0;
                const f32x4 g0 = acc[ai][0][m][0], g1 = acc[ai][0][m][1], u0 = acc[ai][1][m][0], u1 = acc[ai][1][m][1];
                u32x4 w; w.x = cvt_pk_bf16(g0[0] * fast_sigmoid(g0[0]) * u0[0], g0[1] * fast_sigmoid(g0[1]) * u0[1]); w.y = cvt_pk_bf16(g0[2] * fast_sigmoid(g0[2]) * u0[2], g0[3] * fast_sigmoid(g0[3]) * u0[3]);
                w.z = cvt_pk_bf16(g1[0] * fast_sigmoid(g1[0]) * u1[0], g1[1] * fast_sigmoid(g1[1]) * u1[1]); w.w = cvt_pk_bf16(g1[2] * fast_sigmoid(g1[2]) * u1[2], g1[3] * fast_sigmoid(g1[3]) * u1[3]);
                *(u32x4*)rowp = w; }
    }
};
struct PDown {
    static constexpr bool PERM = true, GATHER = false; static constexpr int K = DFF, LDA = DFF, LDB = DFF;
    const bf16_t* HID; const bf16_t* WDN; const float* GATE; bf16_t* YEXP; int G, c;
    __device__ __forceinline__ bool next(int i, Unit& u) const { const int L = i * G + c; if (L >= 256 * 4) return false; pg8::tile_order(L, 256, 4, u.pm, u.pn); int e, rb; moe_tile(u.pm, e, rb); u.z = rb; return true; }
    __device__ __forceinline__ const bf16_t* a_base(const Unit& u) const { return HID + (size_t)u.z * DFF; }
    __device__ __forceinline__ const bf16_t* b_base(const Unit& u) const { return WDN + ((size_t)(u.pm >> 4) * D + (size_t)u.pn * 256) * DFF; }
    __device__ __forceinline__ int a_row(const Unit&, int r) const { return r; }
    __device__ __forceinline__ void epi(const f32x4 (&acc)[2][2][4][2], const Unit& u, int wr, int wc, int fr, int fq) const {
        const int row0 = u.z + wr * 64 + fr, col0 = u.pn * 256 + wc * 32 + 8 * fq;
#pragma unroll
        for (int ai = 0; ai < 2; ++ai)
#pragma unroll
            for (int m = 0; m < 4; ++m) { const int row = row0 + ai * 128 + m * 16; const float gt = GATE[row]; bf16_t* rowp = YEXP + (size_t)row * D + col0;
#pragma unroll
                for (int bj = 0; bj < 2; ++bj) { const f32x4 v0 = acc[ai][bj][m][0] * gt, v1 = acc[ai][bj][m][1] * gt;
                    u32x4 w; w.x = cvt_pk_bf16(v0[0], v0[1]); w.y = cvt_pk_bf16(v0[2], v0[3]); w.z = cvt_pk_bf16(v1[0], v1[1]); w.w = cvt_pk_bf16(v1[2], v1[3]);
                    *(u32x4*)(rowp + bj * 128) = w; } }
    }
};

struct Ctx { LAS unsigned char* lds; int tid, lane, wave, vcu, G; };

__device__ __forceinline__ void s5_param(const Args& a, int d, int g, int p, float& lr, float& li, float& cbr, float& cbi) {
    const float step = expf(a.log_step[d * 16 + g]); const float ar = a.a_re[(d * 16 + g) * 64 + p], ai = a.a_im[(d * 16 + g) * 64 + p];
    lr = ar * step; li = ai * step;
    float s, c; sincosf(li, &s, &c);
    const float em1 = expm1f(lr), e = em1 + 1.0f; const float s2 = sinf(0.5f * li); const float cm1 = -2.0f * s2 * s2;
    const float nr = em1 * c + cm1, ni = e * s, den = ar * ar + ai * ai;
    cbr = (nr * ar + ni * ai) / den; cbi = (ni * ar - nr * ai) / den;
}
__device__ __forceinline__ void cpow(float lr, float li, float e, float& pr, float& pi) { const float m = expf(lr * e); float s, c; sincosf(li * e, &s, &c); pr = m * c; pi = m * s; }

__device__ __forceinline__ void transpose_item(const float* W, int N, bf16_t* WT, int ldt, int k0, int n0, int row_off, LAS float* scr, int lane) {
#pragma unroll 8
    for (int i = 0; i < 32; ++i) { const int kk = 2 * i + (lane >> 5); scr[kk * 33 + (lane & 31)] = W[(size_t)(k0 + kk) * N + n0 + (lane & 31)]; }
    LDS_WAIT(); asm volatile("" ::: "memory");
    const int c = lane & 7;
#pragma unroll
    for (int j = 0; j < 4; ++j) { const int n = (lane >> 3) + 8 * j; const LAS float* s = scr + (8 * c) * 33 + n;
        u32x4 o; o.x = pk2(s[0 * 33], s[1 * 33]); o.y = pk2(s[2 * 33], s[3 * 33]); o.z = pk2(s[4 * 33], s[5 * 33]); o.w = pk2(s[6 * 33], s[7 * 33]);
        *(u32x4*)(WT + (size_t)(row_off + n) * ldt + k0 + 8 * c) = o; }
    LDS_WAIT(); asm volatile("" ::: "memory");
}

__device__ __forceinline__ void phase0(const Args& a, const Ctx& F) {
    unsigned char* ws = a.ws;
    for (int unit = F.vcu; unit < 96 + 1024 + 4; unit += F.G) {
        if (unit >= 96 + 1024) {
            const int idx = (unit - 96 - 1024) * 512 + F.tid, d = idx >> 10, g = (idx >> 6) & 15, p = idx & 63;
            float lr, li, cbr, cbi; s5_param(a, d, g, p, lr, li, cbr, cbi);
            ((f32x4*)(ws + WS_PAR))[idx] = (f32x4){lr, li, cbr, cbi};
        } else if (unit < 96) {
            LAS float* S = (LAS float*)(F.lds);
            LAS float* R = (LAS float*)(F.lds + 5 * 1024 * 4);
            for (int i = F.tid; i < 5 * 1024; i += 512) { const int v = i >> 10, k = i & 1023; const float cv = v < 4 ? a.c[v * 1024 + k] : a.c_ctx[k]; S[i] = cv / (1.0f + expf(-cv)); }
            __syncthreads();
            const int n = unit * 64 + F.lane; float acc[5] = {0.f, 0.f, 0.f, 0.f, 0.f};
            const float* wp = a.w_ada + (size_t)(F.wave * 128) * 6144 + n;
#pragma unroll 8
            for (int k = 0; k < 128; ++k) { const float wv = wp[(size_t)k * 6144];
#pragma unroll
                for (int v = 0; v < 5; ++v) acc[v] += S[v * 1024 + F.wave * 128 + k] * wv; }
#pragma unroll
            for (int v = 0; v < 5; ++v) R[(F.wave * 5 + v) * 64 + F.lane] = acc[v];
            __syncthreads();
            if (F.tid < 320) { const int v = F.tid >> 6; float s = a.b_ada[n];
#pragma unroll
                for (int w = 0; w < 8; ++w) s += R[(w * 5 + v) * 64 + F.lane];
                ((float*)(ws + WS_MOD))[v * 6144 + n] = s; }
            __syncthreads();
        } else {
            const int u2 = unit - 96, d = u2 >> 9, g = (u2 >> 5) & 15, dl = 2 * (u2 & 31) + (F.tid >> 8), t = F.tid & 255, h = t >> 4, hp = t & 15;
            LAS float* PB = (LAS float*)(F.lds);
            if (t < 64) { float lr, li, cbr, cbi, pr, pi; s5_param(a, d, g, t, lr, li, cbr, cbi); cpow(lr, li, (float)dl, pr, pi);
                PB[((F.tid >> 8) * 64 + t) * 2 + 0] = pr * cbr - pi * cbi; PB[((F.tid >> 8) * 64 + t) * 2 + 1] = pr * cbi + pi * cbr; }
            __syncthreads();
            const float* cre = a.c_re + ((size_t)(d * 16 + g) * 16 + h) * 64; const float* cim = a.c_im + ((size_t)(d * 16 + g) * 16 + h) * 64;
            const float* bre = a.b_re + (size_t)(d * 16 + g) * 64 * 16 + hp; const float* bim = a.b_im + (size_t)(d * 16 + g) * 64 * 16 + hp;
            float sum = 0.f;
#pragma unroll 8
            for (int p = 0; p < 64; ++p) { const float pbr = PB[((F.tid >> 8) * 64 + p) * 2], pbi = PB[((F.tid >> 8) * 64 + p) * 2 + 1]; const float cr = cre[p], ci = cim[p];
                const float xr = cr * pbr - ci * pbi, xi = cr * pbi + ci * pbr; sum += xr * bre[p * 16] - xi * bim[p * 16]; }
            ((float*)(ws + WS_KTAB))[((size_t)((d * 16 + g) * 64 + dl)) * 256 + t] = sum;
            __syncthreads();
        }
    }
    LAS float* scr = (LAS float*)(F.lds + F.wave * 16384);
    const int gw = F.vcu * NWAVES + F.wave, NGW = F.G * NWAVES;
    constexpr int I_IN = 16 * 56, I_OUT = 16 * 32, I_GLU = 4 * 8, I_E = 16 * 88  , I_MOE = 16 * I_E;
    constexpr int NITEMS = I_IN + I_OUT + I_GLU + 3 * I_MOE;
    for (int it = gw; it < NITEMS; it += NGW) {
        int r = it;
        if (r < I_IN) { const int kb = r / 56, nb = r % 56; transpose_item(a.w_in, INC, (bf16_t*)(ws + WS_WINT), D, 64 * kb, 32 * nb, 32 * nb, scr, F.lane); continue; } r -= I_IN;
        if (r < I_OUT) { const int kb = r / 32, nb = r % 32; transpose_item(a.w_out, D, (bf16_t*)(ws + WS_WOUTT), D, 64 * kb, 32 * nb, 32 * nb, scr, F.lane); continue; } r -= I_OUT;
        if (r < I_GLU) { const int kb = r / 8, nb = r % 8; transpose_item(a.w_glu, S5W, (bf16_t*)(ws + WS_WGLUT), S5W, 64 * kb, 32 * nb, 32 * nb, scr, F.lane); continue; } r -= I_GLU;
        if (r < 2 * I_MOE) { const int s = r / I_MOE; r -= s * I_MOE; const int e = r / I_E, rr = r % I_E, kb = rr / 88, nb = rr % 88, n0 = 32 * nb;
            transpose_item((s ? a.w_up : a.w_gate) + (size_t)e * D * DFF, DFF, (bf16_t*)(ws + WS_WGU) + (size_t)e * 5632 * D, D, 64 * kb, n0, 256 * (n0 >> 7) + 128 * s + (n0 & 127), scr, F.lane); continue; }
        r -= 2 * I_MOE;
        { const int e = r / I_E, rr = r % I_E, kb = rr / 32, nb = rr % 32;
            transpose_item(a.w_down + (size_t)e * DFF * D, D, (bf16_t*)(ws + WS_WDN) + (size_t)e * D * DFF, DFF, 64 * kb, 32 * nb, 32 * nb, scr, F.lane); }
    }
    for (int i = (F.vcu * 512 + F.tid) * 4; i < NHEAD * 128 * 128; i += F.G * 512 * 4) { const f32x4 v = *(const f32x4*)(a.gm_ws + i); u32x2 o; o.x = pk2(v[0], v[1]); o.y = pk2(v[2], v[3]); *(u32x2*)((bf16_t*)(ws + WS_WSGM) + i) = o; }
}

__device__ __forceinline__ void modulate_row_bf16(const float* xrow, const float* sh, const float* sc, bf16_t* orow, int lane) {
    const f32x4* xr = (const f32x4*)xrow + lane;
    f32x4 v[4]; float s = 0.f;
#pragma unroll
    for (int j = 0; j < 4; ++j) { v[j] = xr[64 * j]; s += (v[j].x + v[j].y) + (v[j].z + v[j].w); }
    const float mean = wave_sum(s) * (1.f / D); float s2 = 0.f;
#pragma unroll
    for (int j = 0; j < 4; ++j) { v[j] = v[j] - mean; s2 += (v[j].x * v[j].x + v[j].y * v[j].y) + (v[j].z * v[j].z + v[j].w * v[j].w); }
    const float rstd = 1.f / sqrtf(wave_sum(s2) * (1.f / D) + LN_EPS);
    unsigned long long* o8 = (unsigned long long*)orow + lane;
#pragma unroll
    for (int j = 0; j < 4; ++j) { const f32x4 sv = ((const f32x4*)sh)[lane + 64 * j], cv = ((const f32x4*)sc)[lane + 64 * j]; const f32x4 o = v[j] * rstd * (cv + 1.0f) + sv;
        o8[64 * j] = (unsigned long long)pk2(o.x, o.y) | ((unsigned long long)pk2(o.z, o.w) << 32); }
}

__device__ __forceinline__ void phase1(const Args& a, const Ctx& F) {
    unsigned char* ws = a.ws; const float* mod = (const float*)(ws + WS_MOD);
    const int gw = F.vcu * NWAVES + F.wave, NGW = F.G * NWAVES;
    for (int m = gw; m < XROWS; m += NGW) {
        const int mi = m < MROWS ? (m >> 13) : 4; const float* src = m < MROWS ? a.x + (size_t)m * D : a.ctx + (size_t)(m - MROWS) * D;
        modulate_row_bf16(src, mod + mi * 6144, mod + mi * 6144 + 1024, (bf16_t*)(ws + WS_XM) + (size_t)m * D, F.lane);
    }
    const float* KT = (const float*)(ws + WS_KTAB); const f32x4* PAR = (const f32x4*)(ws + WS_PAR);
    bf16_t* BTG = (bf16_t*)(ws + WS_BTG);
    const int gt = F.vcu * 512 + F.tid, NGT = F.G * 512;
    constexpr int NA = 16 * 1024 * 128, NBI = 16 * 64 * 32, NC = 16 * 256 * 128;
    for (int it = gt; it < NA + NBI + NC; it += NGT) {
        if (it < NA) {
            const int g = it >> 17, n = (it >> 7) & 1023, k0 = (it & 127) * 8, j = n >> 4, h = n & 15, i = k0 >> 4, hp0 = k0 & 15;
            float o[8];
#pragma unroll
            for (int e = 0; e < 8; ++e) o[e] = 0.f;
            if (i <= j) { const float* kf = KT + ((size_t)((0 * 16 + g) * 64 + (j - i))) * 256 + h * 16 + hp0;
#pragma unroll
                for (int e = 0; e < 8; ++e) o[e] += kf[e]; }
            if (i >= j) { const float* kb2 = KT + ((size_t)((1 * 16 + g) * 64 + (i - j))) * 256 + h * 16 + hp0;
#pragma unroll
                for (int e = 0; e < 8; ++e) o[e] += kb2[e]; }
            if (i == j && h >= hp0 && h < hp0 + 8) { const float dv = a.s5_d[g * 16 + h];
#pragma unroll
                for (int e = 0; e < 8; ++e) o[e] += (hp0 + e == h) ? dv : 0.f; }
            u32x4 w; w.x = pk2(o[0], o[1]); w.y = pk2(o[2], o[3]); w.z = pk2(o[4], o[5]); w.w = pk2(o[6], o[7]);
            *(u32x4*)(BTG + ((size_t)(g * BT_LD + n) * BT_LD + k0)) = w;
        } else if (it < NA + NBI) {
            const int r = it - NA, g = r >> 11, j = (r >> 5) & 63, q0 = (r & 31) * 8, d = q0 >> 7, part = (q0 >> 6) & 1, p0 = q0 & 63; const float ex = d == 0 ? (float)(j + 1) : (float)(TCH - j);
            float pr[8], pi[8];
#pragma unroll
            for (int e = 0; e < 8; ++e) { const f32x4 pa = PAR[(d * 16 + g) * 64 + p0 + e]; cpow(pa.x, pa.y, ex, pr[e], pi[e]); }
            for (int h = 0; h < 16; ++h) {
                const float* cre = a.c_re + ((size_t)(d * 16 + g) * 16 + h) * 64 + p0; const float* cim = a.c_im + ((size_t)(d * 16 + g) * 16 + h) * 64 + p0;
                float o[8];
#pragma unroll
                for (int e = 0; e < 8; ++e) { const float cr = cre[e], ci = cim[e]; o[e] = part == 0 ? (cr * pr[e] - ci * pi[e]) : -(cr * pi[e] + ci * pr[e]); }
                u32x4 w; w.x = pk2(o[0], o[1]); w.y = pk2(o[2], o[3]); w.z = pk2(o[4], o[5]); w.w = pk2(o[6], o[7]);
                *(u32x4*)(BTG + ((size_t)(g * BT_LD + j * 16 + h) * BT_LD + 1024 + q0)) = w;
            }
        } else {
            const int r = it - NA - NBI, g = r >> 15, q = (r >> 7) & 255, k0 = (r & 127) * 8, d = q >> 7, part = (q >> 6) & 1, p = q & 63, i = k0 >> 4, hp0 = k0 & 15; const float ex = d == 0 ? (float)(TCH - 1 - i) : (float)i;
            const f32x4 pa = PAR[(d * 16 + g) * 64 + p]; float pr, pi; cpow(pa.x, pa.y, ex, pr, pi);
            const float wr_ = pr * pa.z - pi * pa.w, wi_ = pr * pa.w + pi * pa.z;
            const float* bre = a.b_re + ((size_t)(d * 16 + g) * 64 + p) * 16 + hp0; const float* bim = a.b_im + ((size_t)(d * 16 + g) * 64 + p) * 16 + hp0;
            float o[8];
#pragma unroll
            for (int e = 0; e < 8; ++e) { const float br = bre[e], bi = bim[e]; o[e] = part == 0 ? (wr_ * br - wi_ * bi) : (wr_ * bi + wi_ * br); }
            u32x4 w; w.x = pk2(o[0], o[1]); w.y = pk2(o[2], o[3]); w.z = pk2(o[4], o[5]); w.w = pk2(o[6], o[7]);
            *(u32x4*)(BTG + ((size_t)(g * BT_LD + 1024 + q) * BT_LD + k0)) = w;
        }
    }
}

typedef short s16x4 __attribute__((ext_vector_type(4)));
__device__ __forceinline__ s16x4 lds_tr16(const LAS unsigned char* p) { return __builtin_bit_cast(s16x4, __builtin_amdgcn_ds_read_tr16_b64_v4i16((LAS s16x4*)p)); }
__device__ __forceinline__ void gmlp_units(const Args& a, const Ctx& F, int ustart, int uend, int ustep) {
    unsigned char* ws = a.ws;
    const bf16_t* ZG = (const bf16_t*)(ws + WS_ZG);
    constexpr int RS = 272;
    LAS unsigned char* VT = F.lds;
    const int lrow = F.tid >> 2, lq = F.tid & 3;
    const int i16 = F.lane & 15, G4 = F.lane >> 4, qloc = F.wave * 16 + i16;
    if (ustart >= uend) return;
    u32x4 raw[4];
    { const int bn = ustart / NHEAD, g = ustart % NHEAD; const u32x4* src = (const u32x4*)(ZG + (size_t)(bn * 128 + lrow) * 1536 + GMW + g * 128 + lq * 32);
#pragma unroll
      for (int j = 0; j < 4; ++j) raw[j] = src[j]; }
    for (int unit = ustart; unit < uend; unit += ustep) {
        const int bn = unit / NHEAD, g = unit % NHEAD, row0 = bn * 128;
        const bf16_t* wsg = (const bf16_t*)(ws + WS_WSGM) + ((size_t)g * 128 + qloc) * 128 + 8 * G4;
        const bf16_t* up = ZG + (size_t)(row0 + qloc) * 1536 + g * 128 + 4 * G4;
        bf16x8 bfrag[4]; u32x2 uw[8];
#pragma unroll
        for (int ks = 0; ks < 4; ++ks) bfrag[ks] = *(const bf16x8*)(wsg + 32 * ks);
#pragma unroll
        for (int cb = 0; cb < 8; ++cb) uw[cb] = *(const u32x2*)(up + cb * 16);
        const float bs = a.gm_bs[g * 128 + qloc];
        {
            float v[32]; float s = 0.f;
#pragma unroll
            for (int j = 0; j < 4; ++j) { const u32x4 w = raw[j]; v[8 * j + 0] = bf_lo(w.x); v[8 * j + 1] = bf_hi(w.x); v[8 * j + 2] = bf_lo(w.y); v[8 * j + 3] = bf_hi(w.y); v[8 * j + 4] = bf_lo(w.z); v[8 * j + 5] = bf_hi(w.z); v[8 * j + 6] = bf_lo(w.w); v[8 * j + 7] = bf_hi(w.w); }
#pragma unroll
            for (int e = 0; e < 32; ++e) s += v[e];
            s += __shfl_xor(s, 1); s += __shfl_xor(s, 2);
            const float mean = s * (1.f / 128.f); float s2 = 0.f;
#pragma unroll
            for (int e = 0; e < 32; ++e) { v[e] -= mean; s2 += v[e] * v[e]; }
            s2 += __shfl_xor(s2, 1); s2 += __shfl_xor(s2, 2);
            const float rstd = 1.f / sqrtf(s2 * (1.f / 128.f) + LN_EPS);
#pragma unroll
            for (int j = 0; j < 4; ++j) { u32x4 w; w.x = pk2(v[8 * j + 0] * rstd, v[8 * j + 1] * rstd); w.y = pk2(v[8 * j + 2] * rstd, v[8 * j + 3] * rstd); w.z = pk2(v[8 * j + 4] * rstd, v[8 * j + 5] * rstd); w.w = pk2(v[8 * j + 6] * rstd, v[8 * j + 7] * rstd);
                *(LAS u32x4*)(VT + lrow * RS + lq * 64 + j * 16) = w; }
        }
        __syncthreads();
        { const int un = unit + ustep; if (un < uend) { const int bn2 = un / NHEAD, g2 = un % NHEAD; const u32x4* src = (const u32x4*)(ZG + (size_t)(bn2 * 128 + lrow) * 1536 + GMW + g2 * 128 + lq * 32);
#pragma unroll
            for (int j = 0; j < 4; ++j) raw[j] = src[j]; } }
        {
            const LAS unsigned char* tb = VT + (8 * G4 + (i16 >> 2)) * RS + (4 * (i16 & 3)) * 2;
            bf16_t* op = (bf16_t*)(ws + WS_AOUT) + (size_t)(row0 + qloc) * D + S5W + g * 128 + 4 * G4;
#pragma unroll
            for (int cb = 0; cb < 8; ++cb) {
                f32x4 acc = (f32x4){0.f, 0.f, 0.f, 0.f};
#pragma unroll
                for (int ks = 0; ks < 4; ++ks) {
                    const s16x4 lo = lds_tr16(tb + (32 * ks) * RS + cb * 32), hi = lds_tr16(tb + (32 * ks + 4) * RS + cb * 32);
                    bf16x8 af; af[0] = lo[0]; af[1] = lo[1]; af[2] = lo[2]; af[3] = lo[3]; af[4] = hi[0]; af[5] = hi[1]; af[6] = hi[2]; af[7] = hi[3];
                    acc = __builtin_amdgcn_mfma_f32_16x16x32_bf16(af, bfrag[ks], acc, 0, 0, 0);
                }
                u32x2 o; o.x = pk2(bf_lo(uw[cb].x) * (acc[0] + bs), bf_hi(uw[cb].x) * (acc[1] + bs)); o.y = pk2(bf_lo(uw[cb].y) * (acc[2] + bs), bf_hi(uw[cb].y) * (acc[3] + bs));
                *(u32x2*)(op + cb * 16) = o;
            }
        }
        __syncthreads();
    }
}

__device__ __forceinline__ void phase_scan(const Args& a, const Ctx& F) {
    unsigned char* ws = a.ws;
    LAS float* E = (LAS float*)F.lds;
    for (int unit = F.vcu; unit < NB * 16 * 2; unit += F.G) {
        const int b = unit >> 5, g = (unit >> 1) & 15, d = unit & 1, p = F.lane, seg = F.wave;
        const f32x4 pa = ((const f32x4*)(ws + WS_PAR))[(d * 16 + g) * 64 + p];
        float tr, ti; cpow(pa.x, pa.y, (float)TCH, tr, ti);
        const float* LOC = (const float*)(ws + WS_LOC) + (size_t)g * AG_ROWS * 256 + d * 128 + p;
        bf16_t* AGs = (bf16_t*)(ws + WS_AG) + (size_t)g * AG_ROWS * AG_LD + 1024 + d * 128 + p;
        float xr[16], xi[16], cr[4], ci[4];
#pragma unroll
        for (int k = 0; k < 16; ++k) { const int pos = seg * 16 + k, c = d == 0 ? pos : 127 - pos; const float* l = LOC + (size_t)(b * 128 + c) * 256; xr[k] = l[0]; xi[k] = l[64]; }
#pragma unroll
        for (int cc = 0; cc < 4; ++cc) { const int c = d == 0 ? cc : 3 - cc; const float* l = LOC + (size_t)(NCL + b * 4 + c) * 256; cr[cc] = l[0]; ci[cc] = l[64]; }
        float er = 0.f, ei = 0.f;
#pragma unroll
        for (int k = 0; k < 16; ++k) { const float nr = tr * er - ti * ei + xr[k], ni = tr * ei + ti * er + xi[k]; er = nr; ei = ni; }
        E[(seg * 64 + p) * 2] = er; E[(seg * 64 + p) * 2 + 1] = ei;
        float sr = 0.f, si = 0.f;
#pragma unroll
        for (int cc = 0; cc < 4; ++cc) { const float nr = tr * sr - ti * si + cr[cc], ni = tr * si + ti * sr + ci[cc]; sr = nr; si = ni; }
        float t16r = tr, t16i = ti;
#pragma unroll
        for (int q = 0; q < 4; ++q) { const float nr = t16r * t16r - t16i * t16i, ni = 2.f * t16r * t16i; t16r = nr; t16i = ni; }
        __syncthreads();
        for (int s2 = 0; s2 < seg; ++s2) { const float pr = E[(s2 * 64 + p) * 2], pi = E[(s2 * 64 + p) * 2 + 1]; const float nr = t16r * sr - t16i * si + pr, ni = t16r * si + t16i * sr + pi; sr = nr; si = ni; }
#pragma unroll
        for (int k = 0; k < 16; ++k) { const int pos = seg * 16 + k, c = d == 0 ? pos : 127 - pos; bf16_t* o = AGs + (size_t)(b * 128 + c) * AG_LD; o[0] = (bf16_t)f2bf(sr); o[64] = (bf16_t)f2bf(si);
            const float nr = tr * sr - ti * si + xr[k], ni = tr * si + ti * sr + xi[k]; sr = nr; si = ni; }
        __syncthreads();
    }
}

__device__ __forceinline__ void phase_ln1(const Args& a, const Ctx& F) {
    unsigned char* ws = a.ws; const float* mod = (const float*)(ws + WS_MOD);
    LAS f32x4* WR4 = (LAS f32x4*)F.lds;
    for (int idx = F.tid; idx < 4096; idx += 512) { const int l = idx & 63, t = idx >> 6, q = t & 3, i = (t >> 2) & 3, j = t >> 4; WR4[idx] = *(const f32x4*)(a.w_router + (size_t)(4 * l + 256 * j + i) * 16 + 4 * q); }
    __syncthreads();
    const int gw = F.vcu * NWAVES + F.wave, NGW = F.G * NWAVES;
    const int b0 = F.lane & 1, b1 = (F.lane >> 1) & 1, b2 = (F.lane >> 2) & 1, b3 = (F.lane >> 3) & 1, myexp = b3 + 2 * b2 + 4 * b1 + 8 * b0;
    f32x4 nv[4];
    if (gw < MROWS) { const f32x4* yr = (const f32x4*)(a.out + (size_t)gw * D) + F.lane;
#pragma unroll
        for (int j = 0; j < 4; ++j) nv[j] = yr[64 * j]; }
    for (int m = gw; m < MROWS; m += NGW) {
        const int b = m >> 13, t = m & (SEQ - 1);
        f32x4* yr = (f32x4*)(a.out + (size_t)m * D) + F.lane;
        f32x4 v[4]; float s = 0.f;
#pragma unroll
        for (int j = 0; j < 4; ++j) { v[j] = nv[j]; s += (v[j].x + v[j].y) + (v[j].z + v[j].w); }
        if (m + NGW < MROWS) { const f32x4* yn = (const f32x4*)(a.out + (size_t)(m + NGW) * D) + F.lane;
#pragma unroll
            for (int j = 0; j < 4; ++j) nv[j] = yn[64 * j]; }
        float mean = wave_sum(s) * (1.f / D); float s2 = 0.f;
#pragma unroll
        for (int j = 0; j < 4; ++j) { v[j] = v[j] - mean; s2 += (v[j].x * v[j].x + v[j].y * v[j].y) + (v[j].z * v[j].z + v[j].w * v[j].w); }
        float rstd = 1.f / sqrtf(wave_sum(s2) * (1.f / D) + LN_EPS);
        s = 0.f;
#pragma unroll
        for (int j = 0; j < 4; ++j) { const f32x4 lgj = ((const f32x4*)a.ln1_g)[F.lane + 64 * j], lbj = ((const f32x4*)a.ln1_b)[F.lane + 64 * j]; v[j] = v[j] * rstd * lgj + lbj; yr[64 * j] = v[j]; s += (v[j].x + v[j].y) + (v[j].z + v[j].w); }
        mean = wave_sum(s) * (1.f / D); s2 = 0.f;
#pragma unroll
        for (int j = 0; j < 4; ++j) { v[j] = v[j] - mean; s2 += (v[j].x * v[j].x + v[j].y * v[j].y) + (v[j].z * v[j].z + v[j].w * v[j].w); }
        rstd = 1.f / sqrtf(wave_sum(s2) * (1.f / D) + LN_EPS);
        const float* sh2 = mod + b * 6144 + 3072; const float* sc2 = mod + b * 6144 + 4096;
        unsigned long long* o8 = (unsigned long long*)((bf16_t*)(ws + WS_HBF) + (size_t)m * D) + F.lane;
        float lg16[16];
#pragma unroll
        for (int e = 0; e < 16; ++e) lg16[e] = 0.f;
#pragma unroll
        for (int j = 0; j < 4; ++j) { const f32x4 sv = ((const f32x4*)sh2)[F.lane + 64 * j], cv = ((const f32x4*)sc2)[F.lane + 64 * j]; const f32x4 h = v[j] * rstd * (cv + 1.0f) + sv;
            o8[64 * j] = (unsigned long long)pk2(h.x, h.y) | ((unsigned long long)pk2(h.z, h.w) << 32);
#pragma unroll
            for (int i = 0; i < 4; ++i) { const float hv = h[i];
#pragma unroll
                for (int q = 0; q < 4; ++q) { const f32x4 w = WR4[((j * 4 + i) * 4 + q) * 64 + F.lane]; lg16[4 * q + 0] += hv * w.x; lg16[4 * q + 1] += hv * w.y; lg16[4 * q + 2] += hv * w.z; lg16[4 * q + 3] += hv * w.w; }
                asm volatile("" ::: "memory"); } }
        float r8[8], r4[4], r2[2], r1;
#pragma unroll
        for (int k = 0; k < 8; ++k) { const float snd = b0 ? lg16[k] : lg16[k + 8], kp = b0 ? lg16[k + 8] : lg16[k]; r8[k] = kp + __shfl_xor(snd, 1); }
#pragma unroll
        for (int k = 0; k < 4; ++k) { const float snd = b1 ? r8[k] : r8[k + 4], kp = b1 ? r8[k + 4] : r8[k]; r4[k] = kp + __shfl_xor(snd, 2); }
#pragma unroll
        for (int k = 0; k < 2; ++k) { const float snd = b2 ? r4[k] : r4[k + 2], kp = b2 ? r4[k + 2] : r4[k]; r2[k] = kp + __shfl_xor(snd, 4); }
        { const float snd = b3 ? r2[0] : r2[1], kp = b3 ? r2[1] : r2[0]; r1 = kp + __shfl_xor(snd, 8); }
        r1 += __shfl_xor(r1, 16); r1 += __shfl_xor(r1, 32);
        float mx = r1;
#pragma unroll
        for (int o = 1; o < 16; o <<= 1) mx = fmaxf(mx, __shfl_xor(mx, o));
        const float ex = expf(r1 - mx); float den = ex;
#pragma unroll
        for (int o = 1; o < 16; o <<= 1) den += __shfl_xor(den, o);
        if (F.lane < 16) ((float*)(ws + WS_AFF))[((size_t)(b * 16 + myexp)) * SEQ + t] = ex / den;
    }
}

__device__ __forceinline__ void topk_unit(const Args& a, const Ctx& F, int be) {
    unsigned char* ws = a.ws;
    LAS unsigned* hist = (LAS unsigned*)F.lds;
    LAS unsigned* bc = hist + 256;
    LAS unsigned* wtot = hist + 272;
    const int b = be >> 4, e = be & 15;
    const float* aff = (const float*)(ws + WS_AFF) + (size_t)be * SEQ + F.tid * 16;
    unsigned key[16];
#pragma unroll
    for (int j = 0; j < 4; ++j) { const u32x4 w = ((const u32x4*)aff)[j]; key[4 * j] = w.x; key[4 * j + 1] = w.y; key[4 * j + 2] = w.z; key[4 * j + 3] = w.w; }
    unsigned prefix = 0u, mask = 0u, kk = CAP;
    for (int pass = 0; pass < 4; ++pass) {
        const int shift = 24 - 8 * pass;
        if (F.tid < 256) hist[F.tid] = 0u;
        __syncthreads();
#pragma unroll
        for (int i = 0; i < 16; ++i) if ((key[i] & mask) == prefix) __hip_atomic_fetch_add(&hist[(key[i] >> shift) & 255u], 1u, __ATOMIC_RELAXED, __HIP_MEMORY_SCOPE_WORKGROUP);
        __syncthreads();
        if (F.wave == 0) {
            const unsigned c0 = hist[4 * F.lane], c1 = hist[4 * F.lane + 1], c2 = hist[4 * F.lane + 2], c3 = hist[4 * F.lane + 3];
            unsigned suf = c0 + c1 + c2 + c3;
#pragma unroll
            for (int o = 1; o < 64; o <<= 1) { const unsigned t = __shfl_down(suf, o); suf += (F.lane + o < 64) ? t : 0u; }
            const unsigned above = suf - (c0 + c1 + c2 + c3);
            if (suf >= kk && above < kk) {
                unsigned cum = above, bin, rem;
                if (cum + c3 >= kk) { bin = 3; rem = kk - cum; } else { cum += c3; if (cum + c2 >= kk) { bin = 2; rem = kk - cum; } else { cum += c2; if (cum + c1 >= kk) { bin = 1; rem = kk - cum; } else { cum += c1; bin = 0; rem = kk - cum; } } }
                bc[0] = 4 * F.lane + bin; bc[1] = rem;
            }
        }
        __syncthreads();
        prefix |= bc[0] << shift; mask |= 0xFFu << shift; kk = bc[1];
        __syncthreads();
    }
    unsigned ngt = 0, neq = 0;
#pragma unroll
    for (int i = 0; i < 16; ++i) { ngt += key[i] > prefix ? 1u : 0u; neq += key[i] == prefix ? 1u : 0u; }
    unsigned sg = ngt, se = neq;
#pragma unroll
    for (int o = 1; o < 64; o <<= 1) { const unsigned tg = __shfl_up(sg, o), te = __shfl_up(se, o); if (F.lane >= o) { sg += tg; se += te; } }
    if (F.lane == 63) { wtot[F.wave * 2] = sg; wtot[F.wave * 2 + 1] = se; }
    __syncthreads();
    unsigned gbase = sg - ngt, ebase = se - neq;
    for (int w = 0; w < F.wave; ++w) { gbase += wtot[w * 2]; ebase += wtot[w * 2 + 1]; }
    int* SEL = (int*)(ws + WS_SEL) + be * CAP; float* GATE = (float*)(ws + WS_GATE) + be * CAP; int* INV = (int*)(ws + WS_INV);
#pragma unroll
    for (int i = 0; i < 16; ++i) {
        const int t = F.tid * 16 + i; int slot = -1;
        if (key[i] > prefix) { slot = (int)(gbase + (ebase < kk ? ebase : kk)); ++gbase; }
        else if (key[i] == prefix) { if (ebase < kk) slot = (int)(gbase + ebase); ++ebase; }
        if (slot >= 0) { SEL[slot] = b * SEQ + t; GATE[slot] = __uint_as_float(key[i]); }
        INV[(size_t)(b * SEQ + t) * NE + e] = slot;
    }
    __syncthreads();
}

__device__ __forceinline__ void phase_final(const Args& a, const Ctx& F) {
    unsigned char* ws = a.ws; const float* mod = (const float*)(ws + WS_MOD);
    const int gw = F.vcu * NWAVES + F.wave, NGW = F.G * NWAVES;
    const bf16_t* YEXP = (const bf16_t*)(ws + WS_YEXP); const int* INV = (const int*)(ws + WS_INV);
    int nslot = gw < MROWS ? INV[(size_t)gw * NE + (F.lane & 15)] : -1;
    for (int m = gw; m < MROWS; m += NGW) {
        const int b = m >> 13; const int slotv = nslot;
        if (m + NGW < MROWS) nslot = INV[(size_t)(m + NGW) * NE + (F.lane & 15)];
        f32x4* xr = (f32x4*)(a.out + (size_t)m * D) + F.lane;
        f32x4 xv[4];
#pragma unroll
        for (int j = 0; j < 4; ++j) xv[j] = xr[64 * j];
        unsigned bal = (unsigned)__ballot(slotv >= 0) & 0xFFFFu;
        f32x4 mo[4];
#pragma unroll
        for (int j = 0; j < 4; ++j) mo[j] = (f32x4){0.f, 0.f, 0.f, 0.f};
        while (bal) {
            int ee[4]; bool on[4];
#pragma unroll
            for (int q = 0; q < 4; ++q) { on[q] = bal != 0u; ee[q] = on[q] ? __builtin_ctz(bal) : ee[0]; bal = on[q] ? (bal & (bal - 1u)) : bal; }
            unsigned long long w[4][4];
#pragma unroll
            for (int q = 0; q < 4; ++q) { const int slot = __builtin_amdgcn_readlane(slotv, ee[q]); const unsigned long long* yr = (const unsigned long long*)(YEXP + ((size_t)((b * 16 + ee[q]) * CAP + slot)) * D) + F.lane;
#pragma unroll
                for (int j = 0; j < 4; ++j) w[q][j] = yr[64 * j]; }
#pragma unroll
            for (int q = 0; q < 4; ++q) if (on[q]) {
#pragma unroll
                for (int j = 0; j < 4; ++j) { const unsigned lo = (unsigned)w[q][j], hi = (unsigned)(w[q][j] >> 32); mo[j].x += bf_lo(lo); mo[j].y += bf_hi(lo); mo[j].z += bf_lo(hi); mo[j].w += bf_hi(hi); } }
        }
        const float* g2 = mod + b * 6144 + 5120;
        f32x4 v[4]; float s = 0.f;
#pragma unroll
        for (int j = 0; j < 4; ++j) { const f32x4 gv = ((const f32x4*)g2)[F.lane + 64 * j]; v[j] = xv[j] * ALPHA + gv * mo[j]; s += (v[j].x + v[j].y) + (v[j].z + v[j].w); }
        const float mean = wave_sum(s) * (1.f / D); float s2 = 0.f;
#pragma unroll
        for (int j = 0; j < 4; ++j) { v[j] = v[j] - mean; s2 += (v[j].x * v[j].x + v[j].y * v[j].y) + (v[j].z * v[j].z + v[j].w * v[j].w); }
        const float rstd = 1.f / sqrtf(wave_sum(s2) * (1.f / D) + LN_EPS);
#pragma unroll
        for (int j = 0; j < 4; ++j) { const f32x4 gv = ((const f32x4*)a.ln2_g)[F.lane + 64 * j], bv = ((const f32x4*)a.ln2_b)[F.lane + 64 * j]; xr[64 * j] = v[j] * rstd * gv + bv; }
    }
}

__global__ void __launch_bounds__(NWAVES * 64, 2) dit_fwd(Args args) {
    extern __shared__ __attribute__((aligned(16))) unsigned char lds[];
    Ctx F;
    F.lds = (LAS unsigned char*)lds;
    F.tid = threadIdx.x; F.lane = F.tid & 63; F.wave = __builtin_amdgcn_readfirstlane(F.tid >> 6);
    F.G = gridDim.x; { const int bx = blockIdx.x; F.vcu = (F.G % 8 == 0) ? (bx % 8) * (F.G / 8) + bx / 8 : bx; }
    volatile LAS unsigned* MISC = (volatile LAS unsigned*)(F.lds + MISC_OFF);
    unsigned char* ws = args.ws;
    gu32* ctl = (gu32*)(ws + WS_CTL);
    for (int u = F.tid; u < (LDS_BYTES - LDSCTL_OFF) / 4; u += NWAVES * 64) ((LAS unsigned*)(F.lds + LDSCTL_OFF))[u] = 0u;
    __syncthreads();
    XcdBarrier bar; bar.bar = (unsigned*)(ctl + CW_BAR); bar.x = 0; bar.st = nullptr;
    if (N_LAUNCHES == 1) bar = xcd_barrier_post((unsigned*)(ctl + CW_BAR), MISC + 8);
    const int lo = args.ph_lo, hi = args.ph_hi;
#ifndef PH_MASK
#define PH_MASK 0xFFFFF
#endif
#define IN(k) (((PH_MASK >> (k)) & 1) && lo <= (k) && (k) < hi)
#ifndef REP_MASK
#define REP_MASK 0
#endif
#ifndef BAR_REPS
#define BAR_REPS 1
#endif
#define REPS(k) (((REP_MASK >> (k)) & 1) ? 2 : 1)
#define SEAM(k) do { if (IN(k) && IN((k) + 1)) { for (int _b = 0; _b < BAR_REPS; ++_b) xcd_barrier(bar); } } while (0)
#define RSEAM(k, rep) do { if (N_LAUNCHES == 1 && (rep) + 1 < REPS(k)) xcd_barrier(bar); } while (0)
    const int G = F.G, cb = (int)blockIdx.x;

#define PH_BODY_0 phase0(args, F);
    if (IN(0)) { { PH_BODY_0 } if (REPS(0) == 2) { RSEAM(0, 0); { PH_BODY_0 } } } SEAM(0);
#define PH_BODY_1 phase1(args, F);
    if (IN(1)) { { PH_BODY_1 } if (REPS(1) == 2) { RSEAM(1, 0); { PH_BODY_1 } } } SEAM(1);
#define PH_BODY_2 PInProj p{(const bf16_t*)(ws + WS_XM), (const bf16_t*)(ws + WS_WINT), (bf16_t*)(ws + WS_AG), (bf16_t*)(ws + WS_ZG), G, cb}; pg8::gemm_phase(F.lds + RING_OFF, p);
    if (IN(2)) { { PH_BODY_2 } if (REPS(2) == 2) { RSEAM(2, 0); { PH_BODY_2 } } } SEAM(2);
#define PH_BODY_3 \
        { PLoc p{(const bf16_t*)(ws + WS_AG), (const bf16_t*)(ws + WS_BTG), (float*)(ws + WS_LOC), G, cb}; pg8::gemm_phase(F.lds + RING_OFF, p); } \
        __syncthreads(); \
         \
        { const int nun = MROWS / 128 * NHEAD; const int heavy = 48 < G ? 48 : 0; const int light = G - heavy; \
          if (cb >= heavy) gmlp_units(args, F, cb - heavy, nun - heavy, light); \
          else gmlp_units(args, F, nun - heavy + cb, nun - heavy + cb + 1, 1); } \

    if (IN(3)) { { PH_BODY_3 } if (REPS(3) == 2) { RSEAM(3, 0); { PH_BODY_3 } } } SEAM(3);
#define PH_BODY_4 phase_scan(args, F);
    if (IN(4)) { { PH_BODY_4 } if (REPS(4) == 2) { RSEAM(4, 0); { PH_BODY_4 } } } SEAM(4);
#define PH_BODY_5 PS5Main p{(const bf16_t*)(ws + WS_AG), (const bf16_t*)(ws + WS_BTG), (bf16_t*)(ws + WS_GY), G, cb}; pg8::gemm_phase(F.lds + RING_OFF, p);
    if (IN(5)) { { PH_BODY_5 } if (REPS(5) == 2) { RSEAM(5, 0); { PH_BODY_5 } } } SEAM(5);
#define PH_BODY_6 PGlu p{(const bf16_t*)(ws + WS_GY), (const bf16_t*)(ws + WS_WGLUT), args.b_glu, (bf16_t*)(ws + WS_AOUT), G, cb}; pg8::gemm_phase(F.lds + RING_OFF, p);
    if (IN(6)) { { PH_BODY_6 } if (REPS(6) == 2) { RSEAM(6, 0); { PH_BODY_6 } } } SEAM(6);
#define PH_BODY_7 POutProj p{(const bf16_t*)(ws + WS_AOUT), (const bf16_t*)(ws + WS_WOUTT), args.x, (const float*)(ws + WS_MOD), args.out, G, cb}; pg8::gemm_phase(F.lds + RING_OFF, p);
    if (IN(7)) { { PH_BODY_7 } if (REPS(7) == 2) { RSEAM(7, 0); { PH_BODY_7 } } } SEAM(7);
#define PH_BODY_8 phase_ln1(args, F);
    if (IN(8)) { { PH_BODY_8 } if (REPS(8) == 2) { RSEAM(8, 0); { PH_BODY_8 } } } SEAM(8);
#define PH_BODY_9 for (int u = F.vcu; u < NB * NE; u += F.G) topk_unit(args, F, u);
    if (IN(9)) { { PH_BODY_9 } if (REPS(9) == 2) { RSEAM(9, 0); { PH_BODY_9 } } } SEAM(9);
#define PH_BODY_10 PGateUp p{(const bf16_t*)(ws + WS_HBF), (const bf16_t*)(ws + WS_WGU), (const int*)(ws + WS_SEL), (bf16_t*)(ws + WS_HID), G, cb}; pg8::gemm_phase(F.lds + RING_OFF, p);
    if (IN(10)) { { PH_BODY_10 } if (REPS(10) == 2) { RSEAM(10, 0); { PH_BODY_10 } } } SEAM(10);
#define PH_BODY_11 PDown p{(const bf16_t*)(ws + WS_HID), (const bf16_t*)(ws + WS_WDN), (const float*)(ws + WS_GATE), (bf16_t*)(ws + WS_YEXP), G, cb}; pg8::gemm_phase(F.lds + RING_OFF, p);
    if (IN(11)) { { PH_BODY_11 } if (REPS(11) == 2) { RSEAM(11, 0); { PH_BODY_11 } } } SEAM(11);
    if (IN(12)) { phase_final(args, F); }
#undef IN
#undef SEAM
}

extern "C" void kernel_launch(void* const* d_in, const int* in_sizes, int n_in, void* d_out, int out_size, void* d_ws, size_t ws_size, hipStream_t stream) {
    static int grid = 0;
    if (grid == 0) {
        if (n_in != 28 || in_sizes[0] != MROWS * D || out_size != MROWS * D || ws_size < WS_END) {
            fprintf(stderr, "kernel_launch: built for 28 inputs, x/out of %d floats, >= %zu bytes of workspace; got n_in %d, in0 %d, out %d, ws %zu; nothing launched\n", MROWS * D, (size_t)WS_END, n_in, n_in > 0 ? in_sizes[0] : -1, out_size, ws_size);
            grid = -1; return; }
        int dev = 0, cus = 0, per_cu = 0;
        if (hipGetDevice(&dev) != hipSuccess || hipDeviceGetAttribute(&cus, hipDeviceAttributeMultiprocessorCount, dev) != hipSuccess) { fprintf(stderr, "kernel_launch: device query failed\n"); grid = -1; return; }
        if (hipFuncSetAttribute((const void*)dit_fwd, hipFuncAttributeMaxDynamicSharedMemorySize, LDS_BYTES) != hipSuccess) { fprintf(stderr, "kernel_launch: hipFuncSetAttribute failed\n"); grid = -1; return; }
        if (hipOccupancyMaxActiveBlocksPerMultiprocessor(&per_cu, (const void*)dit_fwd, NWAVES * 64, LDS_BYTES) != hipSuccess || per_cu < 1)
            fprintf(stderr, "kernel_launch: note: occupancy query reports %d workgroups per CU\n", per_cu);
        (void)hipGetLastError();
        grid = cus;
    }
    if (grid < 0) return;
    if (hipMemsetAsync((char*)d_ws + WS_CTL, 0, CTL_ZERO_BYTES, stream) != hipSuccess) { fprintf(stderr, "kernel_launch: hipMemsetAsync failed\n"); return; }
    Args a{};
    const float** ap = (const float**)&a;
    for (int i = 0; i < 28; ++i) ap[i] = (const float*)d_in[i];
    a.out = (float*)d_out; a.ws = (unsigned char*)d_ws;
    for (int li = 0; li < N_LAUNCHES; ++li) {
        a.ph_lo = (N_LAUNCHES == 1) ? 0 : li; a.ph_hi = (N_LAUNCHES == 1) ? NPH : li + 1;
        hipLaunchKernelGGL(dit_fwd, dim3(grid), dim3(NWAVES * 64), LDS_BYTES, stream, a);
        const hipError_t le = hipPeekAtLastError();
        if (le != hipSuccess) { fprintf(stderr, "kernel_launch: launch %d failed: %s\n", li, hipGetErrorName(le)); break; }
    }
}
```

```cpp
#include <hip/hip_runtime.h>
#include <cstdio>
#include <cstdint>

#ifndef MK_N_LAUNCHES
#define MK_N_LAUNCHES 1
#endif

namespace pg8 {
#define PG8_LAS __attribute__((address_space(3)))
typedef unsigned short bf16_t;
typedef short bf16x8 __attribute__((ext_vector_type(8)));
typedef float f32x4 __attribute__((ext_vector_type(4)));
typedef float f32x2 __attribute__((ext_vector_type(2)));
typedef unsigned u32x4 __attribute__((ext_vector_type(4)));
typedef unsigned u32x2 __attribute__((ext_vector_type(2)));
typedef int v4i32 __attribute__((ext_vector_type(4)));
typedef int v8i32 __attribute__((ext_vector_type(8)));
constexpr int BM = 256, BK = 64, HALF = 128, HTB = HALF * BK * 2  , STAGE_BYTES = 8 * HTB, NXCD = 8, WGM = 8;

__host__ __device__ __forceinline__ int lds_byte(int r, int c) { const int st = (r >> 4) * 2 + (c >> 5), rr = r & 15, cc = c & 31, ob = rr * 64 + cc * 2; return st * 1024 + (ob ^ (((ob >> 9) & 1) << 5)); }
__host__ __device__ __forceinline__ void stage_rc(int b, int& R, int& C) { const int st = b / 1024, sb = b % 1024, swz = sb ^ (((sb >> 9) & 1) << 5); R = (st >> 1) * 16 + swz / 64; C = (st & 1) * 32 + (swz % 64) / 2; }
__host__ __device__ __forceinline__ int perm32(int rho) { const int n = rho >> 4, i = rho & 15; return 8 * (i >> 2) + 4 * n + (i & 3); }

struct Unit { int pm, pn, z; };

__device__ __forceinline__ void tile_order(int L, int nM, int nN, int& pm, int& pn) {
    const int nwg = nM * nN; int wgid = L;
    { const int q = nwg / NXCD, r = nwg % NXCD, xcd = wgid % NXCD, off = wgid / NXCD; wgid = (xcd < r ? xcd * (q + 1) : r * (q + 1) + (xcd - r) * q) + off; }
    const int nig = WGM * nN, gid = wgid / nig, fm = gid * WGM, gsz = (nM - fm) < WGM ? (nM - fm) : WGM;
    pm = fm + ((wgid % nig) % gsz); pn = (wgid % nig) / gsz;
}

__device__ __forceinline__ unsigned cvt_pk_bf16(float lo, float hi) { unsigned r; asm volatile("v_cvt_pk_bf16_f32 %0, %1, %2" : "=v"(r) : "v"(lo), "v"(hi)); return r; }
__device__ __forceinline__ float bf_lo(unsigned w) { return __uint_as_float(w << 16); }
__device__ __forceinline__ float bf_hi(unsigned w) { return __uint_as_float(w & 0xffff0000u); }
__device__ __forceinline__ float fast_sigmoid(float x) { return __builtin_amdgcn_rcpf(1.0f + __builtin_amdgcn_exp2f(-1.44269504f * x)); }
__device__ __forceinline__ float gelu_tanh(float x) { const float u = x * (1.0f + 0.044715f * x * x) * 1.5957691216f; return x * fast_sigmoid(u); }

template <class P>
__device__ __forceinline__ void gemm_phase(PG8_LAS unsigned char* lds, const P& p) {
    const int tid = threadIdx.x, wid = __builtin_amdgcn_readfirstlane(tid >> 6), lane = tid & 63, wr = wid >> 2, wc = wid & 3, fr = lane & 15, fq = lane >> 4;
    constexpr int ESZ = P::FP8 ? 1 : 2;
    constexpr int K = P::K, nt = K * ESZ / 128, lda = P::LDA * ESZ, ldb = P::LDB * ESZ;
    static_assert((K * ESZ) % 256 == 0 && nt >= 4, "K bytes multiple of 256, >= 512");
    int Rr[2], Cc[2]; unsigned voB[2];
#pragma unroll
    for (int i = 0; i < 2; ++i) { int R, C; stage_rc(tid * 16 + i * 8192, R, C); Rr[i] = R; Cc[i] = C; const int Rb = P::PERM ? ((R & ~31) + perm32(R & 31)) : R; voB[i] = (unsigned)(Rb * ldb + C * 2); }
    unsigned voA[2][2], nvoA[2][2];
#define PG8_SETVOA(v, u) do { _Pragma("unroll") for (int _h = 0; _h < 2; ++_h) _Pragma("unroll") for (int _i = 0; _i < 2; ++_i) { const int _r = _h * HALF + Rr[_i]; \
        unsigned _row; if constexpr (P::GATHER) _row = (unsigned)p.a_row(u, _r); else _row = (unsigned)_r; v[_h][_i] = _row * (unsigned)lda + (unsigned)Cc[_i] * 2u; } } while (0)
    const size_t kstep = (size_t)(BK * 2);
    const size_t hstepB = (size_t)HALF * ldb;
    const unsigned ldsw = (unsigned)wid * 1024u;
    const int aoff = lds_byte(wr * 64 + fr, fq * 8), boff = lds_byte(wc * 32 + fr, fq * 8);
#define PG8_SA(b, h) (((b) * 2 + (h)) * HTB)
#define PG8_SB(b, h) ((4 + (b) * 2 + (h)) * HTB)
#define PG8_STAGE(bufoff, gbase, v0, v1) do { \
        __builtin_amdgcn_global_load_lds((const unsigned*)((const char*)(gbase) + (v0)), (PG8_LAS unsigned*)(lds + (bufoff) + ldsw), 16, 0, 0); \
        __builtin_amdgcn_global_load_lds((const unsigned*)((const char*)(gbase) + (v1)), (PG8_LAS unsigned*)(lds + (bufoff) + ldsw + 8192), 16, 0, 0); } while (0)
#define PG8_STAGE_A(bufoff, gbase, V, h) PG8_STAGE(bufoff, gbase, V[h][0], V[h][1])
#define PG8_STAGE_B(bufoff, gbase) PG8_STAGE(bufoff, gbase, voB[0], voB[1])
#define PG8_LDA(dst, b, h) do { _Pragma("unroll") for (int m = 0; m < 4; ++m) { dst[m].lo = *(const PG8_LAS v4i32*)(lds + PG8_SA(b, h) + aoff + m * 2048); dst[m].hi = *(const PG8_LAS v4i32*)(lds + PG8_SA(b, h) + aoff + m * 2048 + 1024); } } while (0)
#define PG8_LDB(dst, b, h) do { _Pragma("unroll") for (int n = 0; n < 2; ++n) { dst[n].lo = *(const PG8_LAS v4i32*)(lds + PG8_SB(b, h) + boff + n * 2048); dst[n].hi = *(const PG8_LAS v4i32*)(lds + PG8_SB(b, h) + boff + n * 2048 + 1024); } } while (0)
#define PG8_MMA(ai, bj, At, Bt) do { __builtin_amdgcn_s_setprio(1); _Pragma("unroll") for (int m = 0; m < 4; ++m) _Pragma("unroll") for (int n = 0; n < 2; ++n) { \
        if constexpr (P::FP8) {   \
            asm volatile("v_mfma_scale_f32_16x16x128_f8f6f4 %0, %1, %2, %0, %3, %4 op_sel_hi:[0,0,0]" : "+v"(acc[ai][bj][m][n]) : "v"(Bt[n]), "v"(At[m]), "v"(sclW), "v"(sclA));   \
        } else { const v4i32 _bl = Bt[n].lo, _bh = Bt[n].hi, _al = At[m].lo, _ah = At[m].hi;     \
                 acc[ai][bj][m][n] = __builtin_amdgcn_mfma_f32_16x16x32_bf16(__builtin_bit_cast(bf16x8, _bl), __builtin_bit_cast(bf16x8, _al), acc[ai][bj][m][n], 0, 0, 0); \
                 acc[ai][bj][m][n] = __builtin_amdgcn_mfma_f32_16x16x32_bf16(__builtin_bit_cast(bf16x8, _bh), __builtin_bit_cast(bf16x8, _ah), acc[ai][bj][m][n], 0, 0, 0); } } \
        __builtin_amdgcn_s_setprio(0); } while (0)
#define PG8_WAIT_V(n) asm volatile("s_waitcnt vmcnt(" #n ")" ::: "memory")
#define PG8_WAIT_L(n) asm volatile("s_waitcnt lgkmcnt(" #n ")" ::: "memory")
#define PG8_BAR __builtin_amdgcn_s_barrier()
#define PG8_SCHED __builtin_amdgcn_sched_barrier(0)
    Unit cur, nxt; int ui = 0;
    if (!p.next(0, cur)) return;
    f32x4 acc[2][2][4][2];
#pragma unroll
    for (int a = 0; a < 2; ++a)
#pragma unroll
        for (int b = 0; b < 2; ++b)
#pragma unroll
            for (int m = 0; m < 4; ++m)
#pragma unroll
                for (int n = 0; n < 2; ++n) acc[a][b][m][n] = (f32x4){0.f, 0.f, 0.f, 0.f};
    v8i32 At[4], B0[2], B1[2];
    int sclW = 0x7F7F7F7F, sclA = 0x7F7F7F7F; if constexpr (P::FP8) sclW = P::SCALE_W;
    asm volatile("" : "+v"(sclW), "+v"(sclA));
    const char* cA = (const char*)p.a_base(cur); const char* cB = (const char*)p.b_base(cur);
    PG8_SETVOA(voA, cur);
    PG8_STAGE_B(PG8_SB(0, 0), cB); PG8_STAGE_B(PG8_SB(0, 1), cB + hstepB); PG8_STAGE_A(PG8_SA(0, 0), cA, voA, 0); PG8_STAGE_A(PG8_SA(0, 1), cA, voA, 1);
    if (wr == 1) PG8_BAR;
    PG8_WAIT_V(2); PG8_BAR;
    PG8_STAGE_B(PG8_SB(1, 0), cB + kstep); PG8_STAGE_A(PG8_SA(1, 0), cA + kstep, voA, 0); PG8_STAGE_B(PG8_SB(1, 1), cB + hstepB + kstep);
    PG8_WAIT_V(6); PG8_BAR;
    for (;;) {
        const bool has_next = p.next(ui + 1, nxt);
        const char* nA = has_next ? (const char*)p.a_base(nxt) : cA; const char* nB = has_next ? (const char*)p.b_base(nxt) : cB;
        if constexpr (P::GATHER) {
            if (has_next) PG8_SETVOA(nvoA, nxt);
            else {
#pragma unroll
                for (int h = 0; h < 2; ++h)
#pragma unroll
                    for (int i = 0; i < 2; ++i) nvoA[h][i] = voA[h][i]; }
        }
#pragma nounroll
        for (int t = 0; t < nt; t += 2) {
            const bool last = (t == nt - 2);
            const char* a1 = cA + (size_t)(t + 1) * kstep;
            const char* a2 = last ? nA : cA + (size_t)(t + 2) * kstep; const char* b2 = last ? nB : cB + (size_t)(t + 2) * kstep;
            const char* a3 = a2 + kstep; const char* b3 = b2 + kstep;
            unsigned wA[2][2];
#pragma unroll
            for (int h = 0; h < 2; ++h)
#pragma unroll
                for (int i = 0; i < 2; ++i) { if constexpr (P::GATHER) wA[h][i] = last ? nvoA[h][i] : voA[h][i]; else wA[h][i] = voA[h][i]; }
            PG8_LDB(B0, 0, 0); PG8_LDB(B1, 0, 1); PG8_SCHED; PG8_LDA(At, 0, 0); PG8_STAGE_A(PG8_SA(1, 1), a1, voA, 1);
            PG8_WAIT_V(8); PG8_WAIT_L(0); PG8_BAR; PG8_MMA(0, 0, At, B0); PG8_MMA(0, 1, At, B1); PG8_BAR; PG8_SCHED;
            PG8_LDA(At, 0, 1); PG8_STAGE_B(PG8_SB(0, 0), b2); PG8_STAGE_B(PG8_SB(0, 1), b2 + hstepB); PG8_STAGE_A(PG8_SA(0, 0), a2, wA, 0);
            PG8_WAIT_V(8); PG8_WAIT_L(0); PG8_BAR; PG8_MMA(1, 0, At, B0); PG8_MMA(1, 1, At, B1); PG8_BAR; PG8_SCHED;
            PG8_LDB(B0, 1, 0); PG8_LDB(B1, 1, 1); PG8_SCHED; PG8_LDA(At, 1, 0); PG8_STAGE_A(PG8_SA(0, 1), a2, wA, 1);
            PG8_WAIT_V(8); PG8_WAIT_L(0); PG8_BAR; PG8_MMA(0, 0, At, B0); PG8_MMA(0, 1, At, B1); PG8_BAR; PG8_SCHED;
            PG8_LDA(At, 1, 1); PG8_STAGE_B(PG8_SB(1, 0), b3); PG8_STAGE_B(PG8_SB(1, 1), b3 + hstepB); PG8_STAGE_A(PG8_SA(1, 0), a3, wA, 0);
            PG8_WAIT_V(8); PG8_WAIT_L(0); PG8_BAR; PG8_MMA(1, 0, At, B0); PG8_MMA(1, 1, At, B1); PG8_BAR; PG8_SCHED;
        }
        if constexpr (P::FP8) asm volatile("s_nop 15\n\ts_nop 15" ::: "memory");
        if (wr == 0) PG8_BAR;
        p.epi(acc, cur, wr, wc, fr, fq);
        if (!has_next) break;
#pragma unroll
        for (int a = 0; a < 2; ++a)
#pragma unroll
            for (int b = 0; b < 2; ++b)
#pragma unroll
                for (int m = 0; m < 4; ++m)
#pragma unroll
                    for (int n = 0; n < 2; ++n) acc[a][b][m][n] = (f32x4){0.f, 0.f, 0.f, 0.f};
        cur = nxt; cA = nA; cB = nB; ++ui;
        if constexpr (P::GATHER) {
#pragma unroll
            for (int h = 0; h < 2; ++h)
#pragma unroll
                for (int i = 0; i < 2; ++i) voA[h][i] = nvoA[h][i]; }
        if (wr == 1) PG8_BAR;
    }
    PG8_WAIT_V(0);
    PG8_BAR;
#undef PG8_SETVOA
#undef PG8_SA
#undef PG8_SB
#undef PG8_STAGE
#undef PG8_STAGE_A
#undef PG8_STAGE_B
#undef PG8_LDA
#undef PG8_LDB
#undef PG8_MMA
#undef PG8_WAIT_V
#undef PG8_WAIT_L
#undef PG8_BAR
#undef PG8_SCHED
}
}
using pg8::bf16_t; using pg8::f32x4; using pg8::f32x2; using pg8::u32x4; using pg8::u32x2; using pg8::bf16x8; using pg8::Unit;
using pg8::cvt_pk_bf16; using pg8::bf_lo; using pg8::bf_hi; using pg8::gelu_tanh; using pg8::fast_sigmoid;

constexpr int NWAVES = 8;
constexpr int D = 1024, NB = 4, SEQ = 8192, CTXL = 256;
constexpr int MROWS = NB * SEQ, CROWS = NB * CTXL, XROWS = MROWS + CROWS;
constexpr int S5W = 256, GMW = 768, INC = 1792, NE = 16, CAP = 1024, DFF = 2816, NHEAD = 6;
constexpr int TCH = 64, NCL = MROWS / TCH, NCC = CROWS / TCH;
constexpr int AG_ROWS = 768, AG_LD = 1280, BT_LD = 1280;
constexpr float ALPHA = 1.189207115f;
constexpr float LN_EPS = 1e-6f;
constexpr int NPH = 13;
constexpr int N_LAUNCHES = MK_N_LAUNCHES;
static_assert(N_LAUNCHES == 1 || N_LAUNCHES == NPH, "MK_N_LAUNCHES is 1 or NPH");

constexpr size_t MiB = 1u << 20;
constexpr size_t WS_CTL = 0, CTL_ZERO_BYTES = 64 * 1024;
constexpr size_t WS_MOD = 1 * MiB;
constexpr size_t WS_PAR = 1 * MiB + 256 * 1024;
constexpr size_t WS_WINT = 2 * MiB;
constexpr size_t WS_WOUTT = 6 * MiB;
constexpr size_t WS_WGLUT = 8 * MiB;
constexpr size_t WS_WSGM = 8 * MiB + 256 * 1024;
constexpr size_t WS_SEL = 9 * MiB;
constexpr size_t WS_GATE = 9 * MiB + 512 * 1024;
constexpr size_t WS_AFF = 10 * MiB;
constexpr size_t WS_INV = 12 * MiB;
constexpr size_t WS_KTAB = 14 * MiB;
constexpr size_t WS_HF8 = 16 * MiB;
constexpr size_t WS_WGU = 48 * MiB;
constexpr size_t WS_WDN = 136 * MiB;
constexpr size_t WS_BIG = 180 * MiB;
constexpr size_t WS_HID = WS_BIG;
constexpr size_t WS_YEXP = WS_BIG + 176 * MiB;
constexpr size_t WS_XM = WS_BIG;
constexpr size_t WS_ZG = WS_BIG + 66 * MiB;
constexpr size_t WS_AG = WS_BIG + 162 * MiB;
constexpr size_t WS_BTG = WS_BIG + 192 * MiB;
constexpr size_t WS_LOC = WS_BIG + 242 * MiB;
constexpr size_t WS_GY = WS_BIG + 254 * MiB;
constexpr size_t WS_AOUT = WS_BIG + 270 * MiB;
constexpr size_t WS_END = WS_BIG + 334 * MiB;
static_assert(WS_AOUT + 64 * MiB <= WS_END && WS_YEXP + 128 * MiB <= WS_END, "overlays inside the temporaries region");
constexpr int CW_BAR = 1024;

constexpr int RING_OFF = 0, RING_BYTES = 131072;
constexpr int LDSCTL_OFF = RING_BYTES, MISC_OFF = LDSCTL_OFF + 320;
constexpr int LDS_BYTES = 147456;

#define GAS __attribute__((address_space(1)))
#define LAS __attribute__((address_space(3)))
typedef GAS unsigned gu32;
#define RLX_AGENT __ATOMIC_RELAXED, __HIP_MEMORY_SCOPE_AGENT
#define LDS_WAIT() asm volatile("s_waitcnt lgkmcnt(0)" ::: "memory")
__device__ __forceinline__ unsigned f2bf(float f) { unsigned u = __builtin_bit_cast(unsigned, f); return (u + 0x7fffu + ((u >> 16) & 1u)) >> 16; }
__device__ __forceinline__ unsigned pk2(float lo, float hi) { return f2bf(lo) | (f2bf(hi) << 16); }
typedef unsigned char fp8_t;
__device__ __forceinline__ unsigned pk4_fp8(float a, float b, float c, float d) {
    a = __builtin_amdgcn_fmed3f(a, -448.f, 448.f); b = __builtin_amdgcn_fmed3f(b, -448.f, 448.f); c = __builtin_amdgcn_fmed3f(c, -448.f, 448.f); d = __builtin_amdgcn_fmed3f(d, -448.f, 448.f);
    int w = 0; w = __builtin_amdgcn_cvt_pk_fp8_f32(a, b, w, false); w = __builtin_amdgcn_cvt_pk_fp8_f32(c, d, w, true); return (unsigned)w; }
__device__ __forceinline__ float wave_sum(float v) {
#pragma unroll
    for (int o = 1; o < 64; o <<= 1) v += __shfl_xor(v, o);
    return v;
}

#define XB_TMO      128
#define XB_XCNT(j)  (256  + 64 * (j))
#define XB_XSUB(j)  (1280 + 64 * (j))
#define XB_XGEN(j)  (2304 + 64 * (j))
#define XB_TOP      3328
#define XB_TOPGEN   3392
#define XCD_BAR_WORDS 3456
#define XB_SPIN_CAP (1u << 18)
__device__ __forceinline__ unsigned xb_ld(unsigned* p)              { return __hip_atomic_load(p, __ATOMIC_RELAXED, __HIP_MEMORY_SCOPE_AGENT); }
__device__ __forceinline__ unsigned xb_add(unsigned* p, unsigned v) { return __hip_atomic_fetch_add(p, v, __ATOMIC_RELAXED, __HIP_MEMORY_SCOPE_AGENT); }
__device__ __forceinline__ unsigned xb_xcc_id() { return (unsigned)__builtin_amdgcn_s_getreg((3 << 11) | 20) & 0xFu; }
#define XB_SPIN(cond, bar) do { unsigned _sp = 0; while (cond) { __builtin_amdgcn_s_sleep(1); \
    if ((++_sp & 255u) == 0u) { if (xb_ld(&(bar)[XB_TMO])) break; if (_sp > XB_SPIN_CAP) { atomicAdd(&(bar)[XB_TMO], 1u); break; } } } } while (0)
struct XcdBarrier { unsigned* bar; unsigned x; volatile LAS unsigned* st; };
__device__ __forceinline__ XcdBarrier xcd_barrier_post(unsigned* bar, volatile LAS unsigned* st) {
    XcdBarrier b; b.bar = bar; b.x = xb_xcc_id(); b.st = st;
    if (threadIdx.x == 0) (void)xb_add(&bar[XB_XCNT(b.x)], 1u);
    return b;
}
__device__ __forceinline__ void xcd_barrier_complete(unsigned* bar, unsigned x, unsigned& nloc, unsigned& nx) {
    const unsigned G = gridDim.x * gridDim.y * gridDim.z;
    unsigned sum, cnt, mine, sp = 0u;
    for (;;) {
        sum = 0u; cnt = 0u; mine = 0u;
#pragma unroll
        for (unsigned j = 0; j < 16; ++j) { const unsigned c = xb_ld(&bar[XB_XCNT(j)]); sum += c; cnt += (c > 0u) ? 1u : 0u; mine = (j == x) ? c : mine; }
        if (sum == G) break;
        __builtin_amdgcn_s_sleep(1);
        if ((++sp & 255u) == 0u) { if (xb_ld(&bar[XB_TMO])) break; if (sp > XB_SPIN_CAP) { atomicAdd(&bar[XB_TMO], 1u); break; } }
    }
    nloc = mine > 0u ? mine : 1u; nx = cnt > 0u ? cnt : 1u;
}
__device__ __forceinline__ void xcd_barrier(const XcdBarrier& b) {
    asm volatile("s_waitcnt vmcnt(0)" ::: "memory");
    __syncthreads();
    if (threadIdx.x == 0) {
        unsigned* bar = b.bar;
        __builtin_amdgcn_s_waitcnt(0);
        unsigned nloc = b.st[0], nx = b.st[1];
        if (nloc == 0u) { xcd_barrier_complete(bar, b.x, nloc, nx); b.st[0] = nloc; b.st[1] = nx; }
        const unsigned old = xb_add(&bar[XB_XSUB(b.x)], 1u);
        const unsigned gen = old / nloc;
        if (old + 1u == (gen + 1u) * nloc) {
            __builtin_amdgcn_fence(__ATOMIC_RELEASE, "agent");
            asm volatile("s_waitcnt vmcnt(0)" ::: "memory");
            const unsigned og = xb_add(&bar[XB_TOP], 1u);
            const unsigned tg = og / nx;
            if (og + 1u == (tg + 1u) * nx) xb_add(&bar[XB_TOPGEN], 1u);
            else XB_SPIN(xb_ld(&bar[XB_TOPGEN]) == tg, bar);
            __builtin_amdgcn_fence(__ATOMIC_ACQUIRE, "agent");
            xb_add(&bar[XB_XGEN(b.x)], 1u);
            asm volatile("s_waitcnt vmcnt(0)" ::: "memory");
        } else {
            XB_SPIN(xb_ld(&bar[XB_XGEN(b.x)]) == gen, bar);
            __builtin_amdgcn_fence(__ATOMIC_ACQUIRE, "agent");
            asm volatile("s_waitcnt vmcnt(0)" ::: "memory");
        }
    }
    __syncthreads();
}

struct Args {
    const float *x, *c, *ctx, *c_ctx, *w_ada, *b_ada, *w_in, *gm_ws, *gm_bs, *a_re, *a_im, *log_step, *b_re, *b_im, *c_re, *c_im, *s5_d, *w_glu, *b_glu, *w_out,
                *ln1_g, *ln1_b, *w_router, *w_gate, *w_up, *w_down, *ln2_g, *ln2_b;
    float* out; unsigned char* ws; int ph_lo, ph_hi;
};

struct PInProj {
    static constexpr bool PERM = true, GATHER = false, FP8 = false; static constexpr int K = D, LDA = D, LDB = D;
    const bf16_t* A; const bf16_t* Bt; bf16_t* AG; bf16_t* ZG; int G, c;
    __device__ __forceinline__ bool next(int i, Unit& u) const { const int L = i * G + c; if (L >= 900) return false; if (L < 4) { u.pm = 128 + L; u.pn = 0; } else pg8::tile_order(L - 4, 128, 7, u.pm, u.pn); u.z = 0; return true; }
    __device__ __forceinline__ const bf16_t* a_base(const Unit& u) const { return A + (size_t)u.pm * 256 * D; }
    __device__ __forceinline__ const bf16_t* b_base(const Unit& u) const { return Bt + (size_t)u.pn * 256 * D; }
    __device__ __forceinline__ int a_row(const Unit&, int r) const { return r; }
    __device__ __forceinline__ void epi(const f32x4 (&acc)[2][2][4][2], const Unit& u, int wr, int wc, int fr, int fq) const {
        const int row0 = u.pm * 256 + wr * 64 + fr;
        if (u.pn == 0) {
#pragma unroll
            for (int ai = 0; ai < 2; ++ai)
#pragma unroll
                for (int m = 0; m < 4; ++m) { const int row = row0 + ai * 128 + m * 16; const int chunk = row < MROWS ? (row >> 6) : (NCL + ((row - MROWS) >> 6)); const int ti = row & 63;
#pragma unroll
                    for (int bj = 0; bj < 2; ++bj) { const int c0 = bj * 128 + wc * 32 + 8 * fq, g = c0 >> 4, h0 = c0 & 15; const f32x4 v0 = acc[ai][bj][m][0], v1 = acc[ai][bj][m][1];
                        u32x4 w; w.x = cvt_pk_bf16(v0[0], v0[1]); w.y = cvt_pk_bf16(v0[2], v0[3]); w.z = cvt_pk_bf16(v1[0], v1[1]); w.w = cvt_pk_bf16(v1[2], v1[3]);
                        *(u32x4*)(AG + ((size_t)(g * AG_ROWS + chunk) * AG_LD + ti * 16 + h0)) = w; } }
        } else {
            const int col0 = (u.pn - 1) * 256 + wc * 32 + 8 * fq;
#pragma unroll
            for (int ai = 0; ai < 2; ++ai)
#pragma unroll
                for (int m = 0; m < 4; ++m) { bf16_t* rowp = ZG + (size_t)(row0 + ai * 128 + m * 16) * 1536 + col0;
#pragma unroll
                    for (int bj = 0; bj < 2; ++bj) { const f32x4 v0 = acc[ai][bj][m][0], v1 = acc[ai][bj][m][1];
                        u32x4 w; w.x = cvt_pk_bf16(gelu_tanh(v0[0]), gelu_tanh(v0[1])); w.y = cvt_pk_bf16(gelu_tanh(v0[2]), gelu_tanh(v0[3]));
                        w.z = cvt_pk_bf16(gelu_tanh(v1[0]), gelu_tanh(v1[1])); w.w = cvt_pk_bf16(gelu_tanh(v1[2]), gelu_tanh(v1[3]));
                        *(u32x4*)(rowp + bj * 128) = w; } }
        }
    }
};
struct PLoc {
    static constexpr bool PERM = false, GATHER = false, FP8 = false; static constexpr int K = 1024, LDA = AG_LD, LDB = BT_LD;
    const bf16_t* AG; const bf16_t* BTG; float* LOC; int G, c;
    __device__ __forceinline__ bool next(int i, Unit& u) const { const int L = i * G + c; if (L >= 48) return false; u.z = L / 3; u.pm = L % 3; u.pn = 0; return true; }
    __device__ __forceinline__ const bf16_t* a_base(const Unit& u) const { return AG + (size_t)(u.z * AG_ROWS + u.pm * 256) * AG_LD; }
    __device__ __forceinline__ const bf16_t* b_base(const Unit& u) const { return BTG + (size_t)(u.z * BT_LD + 1024) * BT_LD; }
    __device__ __forceinline__ int a_row(const Unit&, int r) const { return r; }
    __device__ __forceinline__ void epi(const f32x4 (&acc)[2][2][4][2], const Unit& u, int wr, int wc, int fr, int fq) const {
        const int row0 = u.pm * 256 + wr * 64 + fr, col0 = wc * 32 + 4 * fq;
#pragma unroll
        for (int ai = 0; ai < 2; ++ai)
#pragma unroll
            for (int m = 0; m < 4; ++m) { float* rowp = LOC + (size_t)(u.z * AG_ROWS + row0 + ai * 128 + m * 16) * 256 + col0;
#pragma unroll
                for (int bj = 0; bj < 2; ++bj)
#pragma unroll
                    for (int n = 0; n < 2; ++n) *(f32x4*)(rowp + bj * 128 + n * 16) = acc[ai][bj][m][n]; }
    }
};
struct PS5Main {
    static constexpr bool PERM = true, GATHER = false, FP8 = false; static constexpr int K = 1280, LDA = AG_LD, LDB = BT_LD;
    const bf16_t* AG; const bf16_t* BTG; bf16_t* GY; int G, c;
    __device__ __forceinline__ bool next(int i, Unit& u) const { const int L = i * G + c; if (L >= 128) return false; u.z = L >> 3; u.pm = (L >> 2) & 1; u.pn = L & 3; return true; }
    __device__ __forceinline__ const bf16_t* a_base(const Unit& u) const { return AG + (size_t)(u.z * AG_ROWS + u.pm * 256) * AG_LD; }
    __device__ __forceinline__ const bf16_t* b_base(const Unit& u) const { return BTG + (size_t)(u.z * BT_LD + u.pn * 256) * BT_LD; }
    __device__ __forceinline__ int a_row(const Unit&, int r) const { return r; }
    __device__ __forceinline__ void epi(const f32x4 (&acc)[2][2][4][2], const Unit& u, int wr, int wc, int fr, int fq) const {
        const int chunk0 = u.pm * 256 + wr * 64 + fr;
#pragma unroll
        for (int ai = 0; ai < 2; ++ai)
#pragma unroll
            for (int m = 0; m < 4; ++m) { const int chunk = chunk0 + ai * 128 + m * 16;
#pragma unroll
                for (int bj = 0; bj < 2; ++bj) { const int n0 = u.pn * 256 + bj * 128 + wc * 32 + 8 * fq, j = n0 >> 4, h0 = n0 & 15; const f32x4 v0 = acc[ai][bj][m][0], v1 = acc[ai][bj][m][1];
                    u32x4 w; w.x = cvt_pk_bf16(gelu_tanh(v0[0]), gelu_tanh(v0[1])); w.y = cvt_pk_bf16(gelu_tanh(v0[2]), gelu_tanh(v0[3]));
                    w.z = cvt_pk_bf16(gelu_tanh(v1[0]), gelu_tanh(v1[1])); w.w = cvt_pk_bf16(gelu_tanh(v1[2]), gelu_tanh(v1[3]));
                    *(u32x4*)(GY + ((size_t)(chunk * TCH + j) * S5W + u.z * 16 + h0)) = w; } }
    }
};
struct PGlu {
    static constexpr bool PERM = true, GATHER = false, FP8 = false; static constexpr int K = 256, LDA = 256, LDB = 256;
    const bf16_t* GY; const bf16_t* Bt; const float* b_glu; bf16_t* AOUT; int G, c;
    __device__ __forceinline__ bool next(int i, Unit& u) const { const int L = i * G + c; if (L >= 128) return false; u.pm = L; u.pn = 0; u.z = 0; return true; }
    __device__ __forceinline__ const bf16_t* a_base(const Unit& u) const { return GY + (size_t)u.pm * 256 * 256; }
    __device__ __forceinline__ const bf16_t* b_base(const Unit&) const { return Bt; }
    __device__ __forceinline__ int a_row(const Unit&, int r) const { return r; }
    __device__ __forceinline__ void epi(const f32x4 (&acc)[2][2][4][2], const Unit& u, int wr, int wc, int fr, int fq) const {
        const int row0 = u.pm * 256 + wr * 64 + fr, col0 = wc * 32 + 8 * fq;
        f32x4 bv[2][2];
#pragma unroll
        for (int bj = 0; bj < 2; ++bj)
#pragma unroll
            for (int n = 0; n < 2; ++n) bv[bj][n] = *(const f32x4*)(b_glu + col0 + bj * 128 + 4 * n);
#pragma unroll
        for (int ai = 0; ai < 2; ++ai)
#pragma unroll
            for (int m = 0; m < 4; ++m) { const int row = row0 + ai * 128 + m * 16;
#pragma unroll
                for (int bj = 0; bj < 2; ++bj) { const u32x4 gw = *(const u32x4*)(GY + (size_t)row * 256 + col0 + bj * 128);
                    const f32x4 v0 = acc[ai][bj][m][0] + bv[bj][0], v1 = acc[ai][bj][m][1] + bv[bj][1];
                    u32x4 w; w.x = cvt_pk_bf16(bf_lo(gw.x) * fast_sigmoid(v0[0]), bf_hi(gw.x) * fast_sigmoid(v0[1])); w.y = cvt_pk_bf16(bf_lo(gw.y) * fast_sigmoid(v0[2]), bf_hi(gw.y) * fast_sigmoid(v0[3]));
                    w.z = cvt_pk_bf16(bf_lo(gw.z) * fast_sigmoid(v1[0]), bf_hi(gw.z) * fast_sigmoid(v1[1])); w.w = cvt_pk_bf16(bf_lo(gw.w) * fast_sigmoid(v1[2]), bf_hi(gw.w) * fast_sigmoid(v1[3]));
                    *(u32x4*)(AOUT + (size_t)row * D + col0 + bj * 128) = w; }
                asm volatile("" ::: "memory"); }
    }
};
struct POutProj {
    static constexpr bool PERM = false, GATHER = false, FP8 = false; static constexpr int K = D, LDA = D, LDB = D;
    const bf16_t* A; const bf16_t* Bt; const float* x; const float* mod; float* Y; int G, c;
    __device__ __forceinline__ bool next(int i, Unit& u) const { const int L = i * G + c; if (L >= 512) return false; pg8::tile_order(L, 128, 4, u.pm, u.pn); u.z = 0; return true; }
    __device__ __forceinline__ const bf16_t* a_base(const Unit& u) const { return A + (size_t)u.pm * 256 * D; }
    __device__ __forceinline__ const bf16_t* b_base(const Unit& u) const { return Bt + (size_t)u.pn * 256 * D; }
    __device__ __forceinline__ int a_row(const Unit&, int r) const { return r; }
    __device__ __forceinline__ void epi(const f32x4 (&acc)[2][2][4][2], const Unit& u, int wr, int wc, int fr, int fq) const {
        const int row0 = u.pm * 256 + wr * 64 + fr, col0 = u.pn * 256 + wc * 32 + 4 * fq;
        const float* g1 = mod + (size_t)(u.pm >> 5) * 6144 + 2048;
        f32x4 gv[2][2];
#pragma unroll
        for (int bj = 0; bj < 2; ++bj)
#pragma unroll
            for (int n = 0; n < 2; ++n) gv[bj][n] = *(const f32x4*)(g1 + col0 + bj * 128 + n * 16);
#pragma unroll
        for (int ai = 0; ai < 2; ++ai)
#pragma unroll
            for (int m = 0; m < 4; ++m) { const size_t off = (size_t)(row0 + ai * 128 + m * 16) * D + col0;
#pragma unroll
                for (int bj = 0; bj < 2; ++bj)
#pragma unroll
                    for (int n = 0; n < 2; ++n) { const f32x4 xv = *(const f32x4*)(x + off + bj * 128 + n * 16); *(f32x4*)(Y + off + bj * 128 + n * 16) = xv * ALPHA + gv[bj][n] * acc[ai][bj][m][n]; }
                asm volatile("" ::: "memory"); }
    }
};
__device__ __forceinline__ void moe_tile(int pmx, int& e, int& rowbase) { e = pmx >> 4; const int b = (pmx >> 2) & 3, mt = pmx & 3; rowbase = (b * 16 + e) * CAP + mt * 256; }
constexpr float WGU_SCALE = 64.f, WDN_SCALE = 128.f;
struct PGateUp {
    static constexpr bool PERM = true, GATHER = true, FP8 = true; static constexpr int K = D, LDA = D, LDB = D, SCALE_W = 0x79797979;
    const fp8_t* HF8; const fp8_t* WGU; const int* SEL; fp8_t* HID; int G, c;
    __device__ __forceinline__ bool next(int i, Unit& u) const { const int L = i * G + c; if (L >= 256 * 22) return false; pg8::tile_order(L, 256, 22, u.pm, u.pn); int e, rb; moe_tile(u.pm, e, rb); u.z = rb; return true; }
    __device__ __forceinline__ const fp8_t* a_base(const Unit&) const { return HF8; }
    __device__ __forceinline__ const fp8_t* b_base(const Unit& u) const { return WGU + ((size_t)(u.pm >> 4) * 5632 + (size_t)u.pn * 256) * D; }
    __device__ __forceinline__ int a_row(const Unit& u, int r) const { return SEL[u.z + r]; }
    __device__ __forceinline__ void epi(const f32x4 (&acc)[2][2][4][2], const Unit& u, int wr, int wc, int fr, int fq) const {
        const int row0 = u.z + wr * 64 + fr, col0 = u.pn * 128 + wc * 32 + 8 * fq;
#pragma unroll
        for (int ai = 0; ai < 2; ++ai)
#pragma unroll
            for (int m = 0; m < 4; ++m) { fp8_t* rowp = HID + (size_t)(row0 + ai * 128 + m * 16) * DFF + col0;
                const f32x4 g0 = acc[ai][0][m][0], g1 = acc[ai][0][m][1], u0 = acc[ai][1][m][0], u1 = acc[ai][1][m][1];
                u32x2 w; w.x = pk4_fp8(g0[0] * fast_sigmoid(g0[0]) * u0[0], g0[1] * fast_sigmoid(g0[1]) * u0[1], g0[2] * fast_sigmoid(g0[2]) * u0[2], g0[3] * fast_sigmoid(g0[3]) * u0[3]);
                w.y = pk4_fp8(g1[0] * fast_sigmoid(g1[0]) * u1[0], g1[1] * fast_sigmoid(g1[1]) * u1[1], g1[2] * fast_sigmoid(g1[2]) * u1[2], g1[3] * fast_sigmoid(g1[3]) * u1[3]);
                *(u32x2*)rowp = w; }
    }
};
struct PDown {
    static constexpr bool PERM = true, GATHER = false, FP8 = true; static constexpr int K = DFF, LDA = DFF, LDB = DFF, SCALE_W = 0x78787878;
    const fp8_t* HID; const fp8_t* WDN; const float* GATE; bf16_t* YEXP; int G, c;
    __device__ __forceinline__ bool next(int i, Unit& u) const { const int L = i * G + c; if (L >= 256 * 4) return false; pg8::tile_order(L, 256, 4, u.pm, u.pn); int e, rb; moe_tile(u.pm, e, rb); u.z = rb; return true; }
    __device__ __forceinline__ const fp8_t* a_base(const Unit& u) const { return HID + (size_t)u.z * DFF; }
    __device__ __forceinline__ const fp8_t* b_base(const Unit& u) const { return WDN + ((size_t)(u.pm >> 4) * D + (size_t)u.pn * 256) * DFF; }
    __device__ __forceinline__ int a_row(const Unit&, int r) const { return r; }
    __device__ __forceinline__ void epi(const f32x4 (&acc)[2][2][4][2], const Unit& u, int wr, int wc, int fr, int fq) const {
        const int row0 = u.z + wr * 64 + fr, col0 = u.pn * 256 + wc * 32 + 8 * fq;
#pragma unroll
        for (int ai = 0; ai < 2; ++ai)
#pragma unroll
            for (int m = 0; m < 4; ++m) { const int row = row0 + ai * 128 + m * 16; const float gt = GATE[row]; bf16_t* rowp = YEXP + (size_t)row * D + col0;
#pragma unroll
                for (int bj = 0; bj < 2; ++bj) { const f32x4 v0 = acc[ai][bj][m][0] * gt, v1 = acc[ai][bj][m][1] * gt;
                    u32x4 w; w.x = cvt_pk_bf16(v0[0], v0[1]); w.y = cvt_pk_bf16(v0[2], v0[3]); w.z = cvt_pk_bf16(v1[0], v1[1]); w.w = cvt_pk_bf16(v1[2], v1[3]);
                    *(u32x4*)(rowp + bj * 128) = w; } }
    }
};

struct Ctx { LAS unsigned char* lds; int tid, lane, wave, vcu, G; };

__device__ __forceinline__ void s5_param(const Args& a, int d, int g, int p, float& lr, float& li, float& cbr, float& cbi) {
    const float step = expf(a.log_step[d * 16 + g]); const float ar = a.a_re[(d * 16 + g) * 64 + p], ai = a.a_im[(d * 16 + g) * 64 + p];
    lr = ar * step; li = ai * step;
    float s, c; sincosf(li, &s, &c);
    const float em1 = expm1f(lr), e = em1 + 1.0f; const float s2 = sinf(0.5f * li); const float cm1 = -2.0f * s2 * s2;
    const float nr = em1 * c + cm1, ni = e * s, den = ar * ar + ai * ai;
    cbr = (nr * ar + ni * ai) / den; cbi = (ni * ar - nr * ai) / den;
}
__device__ __forceinline__ void cpow(float lr, float li, float e, float& pr, float& pi) { const float m = expf(lr * e); float s, c; sincosf(li * e, &s, &c); pr = m * c; pi = m * s; }

__device__ __forceinline__ void transpose_item(const float* W, int N, bf16_t* WT, int ldt, int k0, int n0, int row_off, LAS float* scr, int lane) {
#pragma unroll 8
    for (int i = 0; i < 32; ++i) { const int kk = 2 * i + (lane >> 5); scr[kk * 33 + (lane & 31)] = W[(size_t)(k0 + kk) * N + n0 + (lane & 31)]; }
    LDS_WAIT(); asm volatile("" ::: "memory");
    const int c = lane & 7;
#pragma unroll
    for (int j = 0; j < 4; ++j) { const int n = (lane >> 3) + 8 * j; const LAS float* s = scr + (8 * c) * 33 + n;
        u32x4 o; o.x = pk2(s[0 * 33], s[1 * 33]); o.y = pk2(s[2 * 33], s[3 * 33]); o.z = pk2(s[4 * 33], s[5 * 33]); o.w = pk2(s[6 * 33], s[7 * 33]);
        *(u32x4*)(WT + (size_t)(row_off + n) * ldt + k0 + 8 * c) = o; }
    LDS_WAIT(); asm volatile("" ::: "memory");
}

__device__ __forceinline__ void transpose_item_fp8(const float* W, int N, fp8_t* WT, int ldt, int k0, int n0, int row_off, float scale, LAS float* scr, int lane) {
#pragma unroll 8
    for (int i = 0; i < 32; ++i) { const int kk = 2 * i + (lane >> 5); scr[kk * 33 + (lane & 31)] = W[(size_t)(k0 + kk) * N + n0 + (lane & 31)]; }
    LDS_WAIT(); asm volatile("" ::: "memory");
    const int c = lane & 3;
#pragma unroll
    for (int j = 0; j < 2; ++j) { const int n = (lane >> 2) + 16 * j; const LAS float* s = scr + (16 * c) * 33 + n;
        u32x4 o; o.x = pk4_fp8(s[0 * 33] * scale, s[1 * 33] * scale, s[2 * 33] * scale, s[3 * 33] * scale); o.y = pk4_fp8(s[4 * 33] * scale, s[5 * 33] * scale, s[6 * 33] * scale, s[7 * 33] * scale);
        o.z = pk4_fp8(s[8 * 33] * scale, s[9 * 33] * scale, s[10 * 33] * scale, s[11 * 33] * scale); o.w = pk4_fp8(s[12 * 33] * scale, s[13 * 33] * scale, s[14 * 33] * scale, s[15 * 33] * scale);
        *(u32x4*)(WT + (size_t)(row_off + n) * ldt + k0 + 16 * c) = o; }
    LDS_WAIT(); asm volatile("" ::: "memory");
}

__device__ __forceinline__ void phase0(const Args& a, const Ctx& F) {
    unsigned char* ws = a.ws;
    for (int unit = F.vcu; unit < 96 + 1024 + 4; unit += F.G) {
        if (unit >= 96 + 1024) {
            const int idx = (unit - 96 - 1024) * 512 + F.tid, d = idx >> 10, g = (idx >> 6) & 15, p = idx & 63;
            float lr, li, cbr, cbi; s5_param(a, d, g, p, lr, li, cbr, cbi);
            ((f32x4*)(ws + WS_PAR))[idx] = (f32x4){lr, li, cbr, cbi};
        } else if (unit < 96) {
            LAS float* S = (LAS float*)(F.lds);
            LAS float* R = (LAS float*)(F.lds + 5 * 1024 * 4);
            for (int i = F.tid; i < 5 * 1024; i += 512) { const int v = i >> 10, k = i & 1023; const float cv = v < 4 ? a.c[v * 1024 + k] : a.c_ctx[k]; S[i] = cv / (1.0f + expf(-cv)); }
            __syncthreads();
            const int n = unit * 64 + F.lane; float acc[5] = {0.f, 0.f, 0.f, 0.f, 0.f};
            const float* wp = a.w_ada + (size_t)(F.wave * 128) * 6144 + n;
#pragma unroll 8
            for (int k = 0; k < 128; ++k) { const float wv = wp[(size_t)k * 6144];
#pragma unroll
                for (int v = 0; v < 5; ++v) acc[v] += S[v * 1024 + F.wave * 128 + k] * wv; }
#pragma unroll
            for (int v = 0; v < 5; ++v) R[(F.wave * 5 + v) * 64 + F.lane] = acc[v];
            __syncthreads();
            if (F.tid < 320) { const int v = F.tid >> 6; float s = a.b_ada[n];
#pragma unroll
                for (int w = 0; w < 8; ++w) s += R[(w * 5 + v) * 64 + F.lane];
                ((float*)(ws + WS_MOD))[v * 6144 + n] = s; }
            __syncthreads();
        } else {
            const int u2 = unit - 96, d = u2 >> 9, g = (u2 >> 5) & 15, dl = 2 * (u2 & 31) + (F.tid >> 8), t = F.tid & 255, h = t >> 4, hp = t & 15;
            LAS float* PB = (LAS float*)(F.lds);
            if (t < 64) { float lr, li, cbr, cbi, pr, pi; s5_param(a, d, g, t, lr, li, cbr, cbi); cpow(lr, li, (float)dl, pr, pi);
                PB[((F.tid >> 8) * 64 + t) * 2 + 0] = pr * cbr - pi * cbi; PB[((F.tid >> 8) * 64 + t) * 2 + 1] = pr * cbi + pi * cbr; }
            __syncthreads();
            const float* cre = a.c_re + ((size_t)(d * 16 + g) * 16 + h) * 64; const float* cim = a.c_im + ((size_t)(d * 16 + g) * 16 + h) * 64;
            const float* bre = a.b_re + (size_t)(d * 16 + g) * 64 * 16 + hp; const float* bim = a.b_im + (size_t)(d * 16 + g) * 64 * 16 + hp;
            float sum = 0.f;
#pragma unroll 8
            for (int p = 0; p < 64; ++p) { const float pbr = PB[((F.tid >> 8) * 64 + p) * 2], pbi = PB[((F.tid >> 8) * 64 + p) * 2 + 1]; const float cr = cre[p], ci = cim[p];
                const float xr = cr * pbr - ci * pbi, xi = cr * pbi + ci * pbr; sum += xr * bre[p * 16] - xi * bim[p * 16]; }
            ((float*)(ws + WS_KTAB))[((size_t)((d * 16 + g) * 64 + dl)) * 256 + t] = sum;
            __syncthreads();
        }
    }
    LAS float* scr = (LAS float*)(F.lds + F.wave * 16384);
    const int gw = F.vcu * NWAVES + F.wave, NGW = F.G * NWAVES;
    constexpr int I_IN = 16 * 56, I_OUT = 16 * 32, I_GLU = 4 * 8, I_E = 16 * 88  , I_MOE = 16 * I_E;
    constexpr int NITEMS = I_IN + I_OUT + I_GLU + 3 * I_MOE;
    for (int it = gw; it < NITEMS; it += NGW) {
        int r = it;
        if (r < I_IN) { const int kb = r / 56, nb = r % 56; transpose_item(a.w_in, INC, (bf16_t*)(ws + WS_WINT), D, 64 * kb, 32 * nb, 32 * nb, scr, F.lane); continue; } r -= I_IN;
        if (r < I_OUT) { const int kb = r / 32, nb = r % 32; transpose_item(a.w_out, D, (bf16_t*)(ws + WS_WOUTT), D, 64 * kb, 32 * nb, 32 * nb, scr, F.lane); continue; } r -= I_OUT;
        if (r < I_GLU) { const int kb = r / 8, nb = r % 8; transpose_item(a.w_glu, S5W, (bf16_t*)(ws + WS_WGLUT), S5W, 64 * kb, 32 * nb, 32 * nb, scr, F.lane); continue; } r -= I_GLU;
        if (r < 2 * I_MOE) { const int s = r / I_MOE; r -= s * I_MOE; const int e = r / I_E, rr = r % I_E, kb = rr / 88, nb = rr % 88, n0 = 32 * nb;
            transpose_item_fp8((s ? a.w_up : a.w_gate) + (size_t)e * D * DFF, DFF, (fp8_t*)(ws + WS_WGU) + (size_t)e * 5632 * D, D, 64 * kb, n0, 256 * (n0 >> 7) + 128 * s + (n0 & 127), WGU_SCALE, scr, F.lane); continue; }
        r -= 2 * I_MOE;
        { const int e = r / I_E, rr = r % I_E, kb = rr / 32, nb = rr % 32;
            transpose_item_fp8(a.w_down + (size_t)e * DFF * D, D, (fp8_t*)(ws + WS_WDN) + (size_t)e * D * DFF, DFF, 64 * kb, 32 * nb, 32 * nb, WDN_SCALE, scr, F.lane); }
    }
    for (int i = (F.vcu * 512 + F.tid) * 4; i < NHEAD * 128 * 128; i += F.G * 512 * 4) { const f32x4 v = *(const f32x4*)(a.gm_ws + i); u32x2 o; o.x = pk2(v[0], v[1]); o.y = pk2(v[2], v[3]); *(u32x2*)((bf16_t*)(ws + WS_WSGM) + i) = o; }
}

__device__ __forceinline__ void modulate_row_bf16(const float* xrow, const float* sh, const float* sc, bf16_t* orow, int lane) {
    const f32x4* xr = (const f32x4*)xrow + lane;
    f32x4 v[4]; float s = 0.f;
#pragma unroll
    for (int j = 0; j < 4; ++j) { v[j] = xr[64 * j]; s += (v[j].x + v[j].y) + (v[j].z + v[j].w); }
    const float mean = wave_sum(s) * (1.f / D); float s2 = 0.f;
#pragma unroll
    for (int j = 0; j < 4; ++j) { v[j] = v[j] - mean; s2 += (v[j].x * v[j].x + v[j].y * v[j].y) + (v[j].z * v[j].z + v[j].w * v[j].w); }
    const float rstd = 1.f / sqrtf(wave_sum(s2) * (1.f / D) + LN_EPS);
    unsigned long long* o8 = (unsigned long long*)orow + lane;
#pragma unroll
    for (int j = 0; j < 4; ++j) { const f32x4 sv = ((const f32x4*)sh)[lane + 64 * j], cv = ((const f32x4*)sc)[lane + 64 * j]; const f32x4 o = v[j] * rstd * (cv + 1.0f) + sv;
        o8[64 * j] = (unsigned long long)pk2(o.x, o.y) | ((unsigned long long)pk2(o.z, o.w) << 32); }
}

__device__ __forceinline__ void phase1(const Args& a, const Ctx& F) {
    unsigned char* ws = a.ws; const float* mod = (const float*)(ws + WS_MOD);
    const int gw = F.vcu * NWAVES + F.wave, NGW = F.G * NWAVES;
    for (int m = gw; m < XROWS; m += NGW) {
        const int mi = m < MROWS ? (m >> 13) : 4; const float* src = m < MROWS ? a.x + (size_t)m * D : a.ctx + (size_t)(m - MROWS) * D;
        modulate_row_bf16(src, mod + mi * 6144, mod + mi * 6144 + 1024, (bf16_t*)(ws + WS_XM) + (size_t)m * D, F.lane);
    }
    const float* KT = (const float*)(ws + WS_KTAB); const f32x4* PAR = (const f32x4*)(ws + WS_PAR);
    bf16_t* BTG = (bf16_t*)(ws + WS_BTG);
    const int gt = F.vcu * 512 + F.tid, NGT = F.G * 512;
    constexpr int NA = 16 * 1024 * 128, NBI = 16 * 64 * 32, NC = 16 * 256 * 128;
    for (int it = gt; it < NA + NBI + NC; it += NGT) {
        if (it < NA) {
            const int g = it >> 17, n = (it >> 7) & 1023, k0 = (it & 127) * 8, j = n >> 4, h = n & 15, i = k0 >> 4, hp0 = k0 & 15;
            float o[8];
#pragma unroll
            for (int e = 0; e < 8; ++e) o[e] = 0.f;
            if (i <= j) { const float* kf = KT + ((size_t)((0 * 16 + g) * 64 + (j - i))) * 256 + h * 16 + hp0;
#pragma unroll
                for (int e = 0; e < 8; ++e) o[e] += kf[e]; }
            if (i >= j) { const float* kb2 = KT + ((size_t)((1 * 16 + g) * 64 + (i - j))) * 256 + h * 16 + hp0;
#pragma unroll
                for (int e = 0; e < 8; ++e) o[e] += kb2[e]; }
            if (i == j && h >= hp0 && h < hp0 + 8) { const float dv = a.s5_d[g * 16 + h];
#pragma unroll
                for (int e = 0; e < 8; ++e) o[e] += (hp0 + e == h) ? dv : 0.f; }
            u32x4 w; w.x = pk2(o[0], o[1]); w.y = pk2(o[2], o[3]); w.z = pk2(o[4], o[5]); w.w = pk2(o[6], o[7]);
            *(u32x4*)(BTG + ((size_t)(g * BT_LD + n) * BT_LD + k0)) = w;
        } else if (it < NA + NBI) {
            const int r = it - NA, g = r >> 11, j = (r >> 5) & 63, q0 = (r & 31) * 8, d = q0 >> 7, part = (q0 >> 6) & 1, p0 = q0 & 63; const float ex = d == 0 ? (float)(j + 1) : (float)(TCH - j);
            float pr[8], pi[8];
#pragma unroll
            for (int e = 0; e < 8; ++e) { const f32x4 pa = PAR[(d * 16 + g) * 64 + p0 + e]; cpow(pa.x, pa.y, ex, pr[e], pi[e]); }
            for (int h = 0; h < 16; ++h) {
                const float* cre = a.c_re + ((size_t)(d * 16 + g) * 16 + h) * 64 + p0; const float* cim = a.c_im + ((size_t)(d * 16 + g) * 16 + h) * 64 + p0;
                float o[8];
#pragma unroll
                for (int e = 0; e < 8; ++e) { const float cr = cre[e], ci = cim[e]; o[e] = part == 0 ? (cr * pr[e] - ci * pi[e]) : -(cr * pi[e] + ci * pr[e]); }
                u32x4 w; w.x = pk2(o[0], o[1]); w.y = pk2(o[2], o[3]); w.z = pk2(o[4], o[5]); w.w = pk2(o[6], o[7]);
                *(u32x4*)(BTG + ((size_t)(g * BT_LD + j * 16 + h) * BT_LD + 1024 + q0)) = w;
            }
        } else {
            const int r = it - NA - NBI, g = r >> 15, q = (r >> 7) & 255, k0 = (r & 127) * 8, d = q >> 7, part = (q >> 6) & 1, p = q & 63, i = k0 >> 4, hp0 = k0 & 15; const float ex = d == 0 ? (float)(TCH - 1 - i) : (float)i;
            const f32x4 pa = PAR[(d * 16 + g) * 64 + p]; float pr, pi; cpow(pa.x, pa.y, ex, pr, pi);
            const float wr_ = pr * pa.z - pi * pa.w, wi_ = pr * pa.w + pi * pa.z;
            const float* bre = a.b_re + ((size_t)(d * 16 + g) * 64 + p) * 16 + hp0; const float* bim = a.b_im + ((size_t)(d * 16 + g) * 64 + p) * 16 + hp0;
            float o[8];
#pragma unroll
            for (int e = 0; e < 8; ++e) { const float br = bre[e], bi = bim[e]; o[e] = part == 0 ? (wr_ * br - wi_ * bi) : (wr_ * bi + wi_ * br); }
            u32x4 w; w.x = pk2(o[0], o[1]); w.y = pk2(o[2], o[3]); w.z = pk2(o[4], o[5]); w.w = pk2(o[6], o[7]);
            *(u32x4*)(BTG + ((size_t)(g * BT_LD + 1024 + q) * BT_LD + k0)) = w;
        }
    }
}

typedef short s16x4 __attribute__((ext_vector_type(4)));
__device__ __forceinline__ s16x4 lds_tr16(const LAS unsigned char* p) { return __builtin_bit_cast(s16x4, __builtin_amdgcn_ds_read_tr16_b64_v4i16((LAS s16x4*)p)); }
__device__ __forceinline__ void gmlp_units(const Args& a, const Ctx& F, int ustart, int uend, int ustep) {
    unsigned char* ws = a.ws;
    const bf16_t* ZG = (const bf16_t*)(ws + WS_ZG);
    constexpr int RS = 272;
    LAS unsigned char* VT = F.lds;
    const int lrow = F.tid >> 2, lq = F.tid & 3;
    const int i16 = F.lane & 15, G4 = F.lane >> 4, qloc = F.wave * 16 + i16;
    if (ustart >= uend) return;
    u32x4 raw[4];
    { const int bn = ustart / NHEAD, g = ustart % NHEAD; const u32x4* src = (const u32x4*)(ZG + (size_t)(bn * 128 + lrow) * 1536 + GMW + g * 128 + lq * 32);
#pragma unroll
      for (int j = 0; j < 4; ++j) raw[j] = src[j]; }
    for (int unit = ustart; unit < uend; unit += ustep) {
        const int bn = unit / NHEAD, g = unit % NHEAD, row0 = bn * 128;
        const bf16_t* wsg = (const bf16_t*)(ws + WS_WSGM) + ((size_t)g * 128 + qloc) * 128 + 8 * G4;
        const bf16_t* up = ZG + (size_t)(row0 + qloc) * 1536 + g * 128 + 4 * G4;
        bf16x8 bfrag[4]; u32x2 uw[8];
#pragma unroll
        for (int ks = 0; ks < 4; ++ks) bfrag[ks] = *(const bf16x8*)(wsg + 32 * ks);
#pragma unroll
        for (int cb = 0; cb < 8; ++cb) uw[cb] = *(const u32x2*)(up + cb * 16);
        const float bs = a.gm_bs[g * 128 + qloc];
        {
            float v[32]; float s = 0.f;
#pragma unroll
            for (int j = 0; j < 4; ++j) { const u32x4 w = raw[j]; v[8 * j + 0] = bf_lo(w.x); v[8 * j + 1] = bf_hi(w.x); v[8 * j + 2] = bf_lo(w.y); v[8 * j + 3] = bf_hi(w.y); v[8 * j + 4] = bf_lo(w.z); v[8 * j + 5] = bf_hi(w.z); v[8 * j + 6] = bf_lo(w.w); v[8 * j + 7] = bf_hi(w.w); }
#pragma unroll
            for (int e = 0; e < 32; ++e) s += v[e];
            s += __shfl_xor(s, 1); s += __shfl_xor(s, 2);
            const float mean = s * (1.f / 128.f); float s2 = 0.f;
#pragma unroll
            for (int e = 0; e < 32; ++e) { v[e] -= mean; s2 += v[e] * v[e]; }
            s2 += __shfl_xor(s2, 1); s2 += __shfl_xor(s2, 2);
            const float rstd = 1.f / sqrtf(s2 * (1.f / 128.f) + LN_EPS);
#pragma unroll
            for (int j = 0; j < 4; ++j) { u32x4 w; w.x = pk2(v[8 * j + 0] * rstd, v[8 * j + 1] * rstd); w.y = pk2(v[8 * j + 2] * rstd, v[8 * j + 3] * rstd); w.z = pk2(v[8 * j + 4] * rstd, v[8 * j + 5] * rstd); w.w = pk2(v[8 * j + 6] * rstd, v[8 * j + 7] * rstd);
                *(LAS u32x4*)(VT + lrow * RS + lq * 64 + j * 16) = w; }
        }
        __syncthreads();
        { const int un = unit + ustep; if (un < uend) { const int bn2 = un / NHEAD, g2 = un % NHEAD; const u32x4* src = (const u32x4*)(ZG + (size_t)(bn2 * 128 + lrow) * 1536 + GMW + g2 * 128 + lq * 32);
#pragma unroll
            for (int j = 0; j < 4; ++j) raw[j] = src[j]; } }
        {
            const LAS unsigned char* tb = VT + (8 * G4 + (i16 >> 2)) * RS + (4 * (i16 & 3)) * 2;
            bf16_t* op = (bf16_t*)(ws + WS_AOUT) + (size_t)(row0 + qloc) * D + S5W + g * 128 + 4 * G4;
#pragma unroll
            for (int cb = 0; cb < 8; ++cb) {
                f32x4 acc = (f32x4){0.f, 0.f, 0.f, 0.f};
#pragma unroll
                for (int ks = 0; ks < 4; ++ks) {
                    const s16x4 lo = lds_tr16(tb + (32 * ks) * RS + cb * 32), hi = lds_tr16(tb + (32 * ks + 4) * RS + cb * 32);
                    bf16x8 af; af[0] = lo[0]; af[1] = lo[1]; af[2] = lo[2]; af[3] = lo[3]; af[4] = hi[0]; af[5] = hi[1]; af[6] = hi[2]; af[7] = hi[3];
                    acc = __builtin_amdgcn_mfma_f32_16x16x32_bf16(af, bfrag[ks], acc, 0, 0, 0);
                }
                u32x2 o; o.x = pk2(bf_lo(uw[cb].x) * (acc[0] + bs), bf_hi(uw[cb].x) * (acc[1] + bs)); o.y = pk2(bf_lo(uw[cb].y) * (acc[2] + bs), bf_hi(uw[cb].y) * (acc[3] + bs));
                *(u32x2*)(op + cb * 16) = o;
            }
        }
        __syncthreads();
    }
}

__device__ __forceinline__ void phase_scan(const Args& a, const Ctx& F) {
    unsigned char* ws = a.ws;
    LAS float* E = (LAS float*)F.lds;
    for (int unit = F.vcu; unit < NB * 16 * 2; unit += F.G) {
        const int b = unit >> 5, g = (unit >> 1) & 15, d = unit & 1, p = F.lane, seg = F.wave;
        const f32x4 pa = ((const f32x4*)(ws + WS_PAR))[(d * 16 + g) * 64 + p];
        float tr, ti; cpow(pa.x, pa.y, (float)TCH, tr, ti);
        const float* LOC = (const float*)(ws + WS_LOC) + (size_t)g * AG_ROWS * 256 + d * 128 + p;
        bf16_t* AGs = (bf16_t*)(ws + WS_AG) + (size_t)g * AG_ROWS * AG_LD + 1024 + d * 128 + p;
        float xr[16], xi[16], cr[4], ci[4];
#pragma unroll
        for (int k = 0; k < 16; ++k) { const int pos = seg * 16 + k, c = d == 0 ? pos : 127 - pos; const float* l = LOC + (size_t)(b * 128 + c) * 256; xr[k] = l[0]; xi[k] = l[64]; }
#pragma unroll
        for (int cc = 0; cc < 4; ++cc) { const int c = d == 0 ? cc : 3 - cc; const float* l = LOC + (size_t)(NCL + b * 4 + c) * 256; cr[cc] = l[0]; ci[cc] = l[64]; }
        float er = 0.f, ei = 0.f;
#pragma unroll
        for (int k = 0; k < 16; ++k) { const float nr = tr * er - ti * ei + xr[k], ni = tr * ei + ti * er + xi[k]; er = nr; ei = ni; }
        E[(seg * 64 + p) * 2] = er; E[(seg * 64 + p) * 2 + 1] = ei;
        float sr = 0.f, si = 0.f;
#pragma unroll
        for (int cc = 0; cc < 4; ++cc) { const float nr = tr * sr - ti * si + cr[cc], ni = tr * si + ti * sr + ci[cc]; sr = nr; si = ni; }
        float t16r = tr, t16i = ti;
#pragma unroll
        for (int q = 0; q < 4; ++q) { const float nr = t16r * t16r - t16i * t16i, ni = 2.f * t16r * t16i; t16r = nr; t16i = ni; }
        __syncthreads();
        for (int s2 = 0; s2 < seg; ++s2) { const float pr = E[(s2 * 64 + p) * 2], pi = E[(s2 * 64 + p) * 2 + 1]; const float nr = t16r * sr - t16i * si + pr, ni = t16r * si + t16i * sr + pi; sr = nr; si = ni; }
#pragma unroll
        for (int k = 0; k < 16; ++k) { const int pos = seg * 16 + k, c = d == 0 ? pos : 127 - pos; bf16_t* o = AGs + (size_t)(b * 128 + c) * AG_LD; o[0] = (bf16_t)f2bf(sr); o[64] = (bf16_t)f2bf(si);
            const float nr = tr * sr - ti * si + xr[k], ni = tr * si + ti * sr + xi[k]; sr = nr; si = ni; }
        __syncthreads();
    }
}

__device__ __forceinline__ void phase_ln1(const Args& a, const Ctx& F, float* xdst) {
    unsigned char* ws = a.ws; const float* mod = (const float*)(ws + WS_MOD);
    LAS f32x4* WR4 = (LAS f32x4*)F.lds;
    for (int idx = F.tid; idx < 4096; idx += 512) { const int l = idx & 63, t = idx >> 6, q = t & 3, i = (t >> 2) & 3, j = t >> 4; WR4[idx] = *(const f32x4*)(a.w_router + (size_t)(4 * l + 256 * j + i) * 16 + 4 * q); }
    __syncthreads();
    const int gw = F.vcu * NWAVES + F.wave, NGW = F.G * NWAVES;
    const int b0 = F.lane & 1, b1 = (F.lane >> 1) & 1, b2 = (F.lane >> 2) & 1, b3 = (F.lane >> 3) & 1, myexp = b3 + 2 * b2 + 4 * b1 + 8 * b0;
    f32x4 nv[4];
    if (gw < MROWS) { const f32x4* yr = (const f32x4*)(a.out + (size_t)gw * D) + F.lane;
#pragma unroll
        for (int j = 0; j < 4; ++j) nv[j] = yr[64 * j]; }
    for (int m = gw; m < MROWS; m += NGW) {
        const int b = m >> 13, t = m & (SEQ - 1);
        f32x4* yr = (f32x4*)(a.out + (size_t)m * D) + F.lane;
        f32x4 v[4]; float s = 0.f;
#pragma unroll
        for (int j = 0; j < 4; ++j) { v[j] = nv[j]; s += (v[j].x + v[j].y) + (v[j].z + v[j].w); }
        if (m + NGW < MROWS) { const f32x4* yn = (const f32x4*)(a.out + (size_t)(m + NGW) * D) + F.lane;
#pragma unroll
            for (int j = 0; j < 4; ++j) nv[j] = yn[64 * j]; }
        float mean = wave_sum(s) * (1.f / D); float s2 = 0.f;
#pragma unroll
        for (int j = 0; j < 4; ++j) { v[j] = v[j] - mean; s2 += (v[j].x * v[j].x + v[j].y * v[j].y) + (v[j].z * v[j].z + v[j].w * v[j].w); }
        float rstd = 1.f / sqrtf(wave_sum(s2) * (1.f / D) + LN_EPS);
        s = 0.f;
#pragma unroll
        for (int j = 0; j < 4; ++j) { const f32x4 lgj = ((const f32x4*)a.ln1_g)[F.lane + 64 * j], lbj = ((const f32x4*)a.ln1_b)[F.lane + 64 * j]; v[j] = v[j] * rstd * lgj + lbj; ((f32x4*)(xdst + (size_t)m * D) + F.lane)[64 * j] = v[j]; s += (v[j].x + v[j].y) + (v[j].z + v[j].w); }
        mean = wave_sum(s) * (1.f / D); s2 = 0.f;
#pragma unroll
        for (int j = 0; j < 4; ++j) { v[j] = v[j] - mean; s2 += (v[j].x * v[j].x + v[j].y * v[j].y) + (v[j].z * v[j].z + v[j].w * v[j].w); }
        rstd = 1.f / sqrtf(wave_sum(s2) * (1.f / D) + LN_EPS);
        const float* sh2 = mod + b * 6144 + 3072; const float* sc2 = mod + b * 6144 + 4096;
        unsigned* o4 = (unsigned*)((fp8_t*)(ws + WS_HF8) + (size_t)m * D) + F.lane;
        float lg16[16];
#pragma unroll
        for (int e = 0; e < 16; ++e) lg16[e] = 0.f;
#pragma unroll
        for (int j = 0; j < 4; ++j) { const f32x4 sv = ((const f32x4*)sh2)[F.lane + 64 * j], cv = ((const f32x4*)sc2)[F.lane + 64 * j]; const f32x4 h = v[j] * rstd * (cv + 1.0f) + sv;
            o4[64 * j] = pk4_fp8(h.x, h.y, h.z, h.w);
#pragma unroll
            for (int i = 0; i < 4; ++i) { const float hv = h[i];
#pragma unroll
                for (int q = 0; q < 4; ++q) { const f32x4 w = WR4[((j * 4 + i) * 4 + q) * 64 + F.lane]; lg16[4 * q + 0] += hv * w.x; lg16[4 * q + 1] += hv * w.y; lg16[4 * q + 2] += hv * w.z; lg16[4 * q + 3] += hv * w.w; }
                asm volatile("" ::: "memory"); } }
        float r8[8], r4[4], r2[2], r1;
#pragma unroll
        for (int k = 0; k < 8; ++k) { const float snd = b0 ? lg16[k] : lg16[k + 8], kp = b0 ? lg16[k + 8] : lg16[k]; r8[k] = kp + __shfl_xor(snd, 1); }
#pragma unroll
        for (int k = 0; k < 4; ++k) { const float snd = b1 ? r8[k] : r8[k + 4], kp = b1 ? r8[k + 4] : r8[k]; r4[k] = kp + __shfl_xor(snd, 2); }
#pragma unroll
        for (int k = 0; k < 2; ++k) { const float snd = b2 ? r4[k] : r4[k + 2], kp = b2 ? r4[k + 2] : r4[k]; r2[k] = kp + __shfl_xor(snd, 4); }
        { const float snd = b3 ? r2[0] : r2[1], kp = b3 ? r2[1] : r2[0]; r1 = kp + __shfl_xor(snd, 8); }
        r1 += __shfl_xor(r1, 16); r1 += __shfl_xor(r1, 32);
        float mx = r1;
#pragma unroll
        for (int o = 1; o < 16; o <<= 1) mx = fmaxf(mx, __shfl_xor(mx, o));
        const float ex = expf(r1 - mx); float den = ex;
#pragma unroll
        for (int o = 1; o < 16; o <<= 1) den += __shfl_xor(den, o);
        if (F.lane < 16) ((float*)(ws + WS_AFF))[((size_t)(b * 16 + myexp)) * SEQ + t] = ex / den;
    }
}

__device__ __forceinline__ void topk_unit(const Args& a, const Ctx& F, int be) {
    unsigned char* ws = a.ws;
    LAS unsigned* hist = (LAS unsigned*)F.lds;
    LAS unsigned* bc = hist + 256;
    LAS unsigned* wtot = hist + 272;
    const int b = be >> 4, e = be & 15;
    const float* aff = (const float*)(ws + WS_AFF) + (size_t)be * SEQ + F.tid * 16;
    unsigned key[16];
#pragma unroll
    for (int j = 0; j < 4; ++j) { const u32x4 w = ((const u32x4*)aff)[j]; key[4 * j] = w.x; key[4 * j + 1] = w.y; key[4 * j + 2] = w.z; key[4 * j + 3] = w.w; }
    unsigned prefix = 0u, mask = 0u, kk = CAP;
    for (int pass = 0; pass < 4; ++pass) {
        const int shift = 24 - 8 * pass;
        if (F.tid < 256) hist[F.tid] = 0u;
        __syncthreads();
#pragma unroll
        for (int i = 0; i < 16; ++i) if ((key[i] & mask) == prefix) __hip_atomic_fetch_add(&hist[(key[i] >> shift) & 255u], 1u, __ATOMIC_RELAXED, __HIP_MEMORY_SCOPE_WORKGROUP);
        __syncthreads();
        if (F.wave == 0) {
            const unsigned c0 = hist[4 * F.lane], c1 = hist[4 * F.lane + 1], c2 = hist[4 * F.lane + 2], c3 = hist[4 * F.lane + 3];
            unsigned suf = c0 + c1 + c2 + c3;
#pragma unroll
            for (int o = 1; o < 64; o <<= 1) { const unsigned t = __shfl_down(suf, o); suf += (F.lane + o < 64) ? t : 0u; }
            const unsigned above = suf - (c0 + c1 + c2 + c3);
            if (suf >= kk && above < kk) {
                unsigned cum = above, bin, rem;
                if (cum + c3 >= kk) { bin = 3; rem = kk - cum; } else { cum += c3; if (cum + c2 >= kk) { bin = 2; rem = kk - cum; } else { cum += c2; if (cum + c1 >= kk) { bin = 1; rem = kk - cum; } else { cum += c1; bin = 0; rem = kk - cum; } } }
                bc[0] = 4 * F.lane + bin; bc[1] = rem;
            }
        }
        __syncthreads();
        prefix |= bc[0] << shift; mask |= 0xFFu << shift; kk = bc[1];
        __syncthreads();
    }
    unsigned ngt = 0, neq = 0;
#pragma unroll
    for (int i = 0; i < 16; ++i) { ngt += key[i] > prefix ? 1u : 0u; neq += key[i] == prefix ? 1u : 0u; }
    unsigned sg = ngt, se = neq;
#pragma unroll
    for (int o = 1; o < 64; o <<= 1) { const unsigned tg = __shfl_up(sg, o), te = __shfl_up(se, o); if (F.lane >= o) { sg += tg; se += te; } }
    if (F.lane == 63) { wtot[F.wave * 2] = sg; wtot[F.wave * 2 + 1] = se; }
    __syncthreads();
    unsigned gbase = sg - ngt, ebase = se - neq;
    for (int w = 0; w < F.wave; ++w) { gbase += wtot[w * 2]; ebase += wtot[w * 2 + 1]; }
    int* SEL = (int*)(ws + WS_SEL) + be * CAP; float* GATE = (float*)(ws + WS_GATE) + be * CAP; int* INV = (int*)(ws + WS_INV);
#pragma unroll
    for (int i = 0; i < 16; ++i) {
        const int t = F.tid * 16 + i; int slot = -1;
        if (key[i] > prefix) { slot = (int)(gbase + (ebase < kk ? ebase : kk)); ++gbase; }
        else if (key[i] == prefix) { if (ebase < kk) slot = (int)(gbase + ebase); ++ebase; }
        if (slot >= 0) { SEL[slot] = b * SEQ + t; GATE[slot] = __uint_as_float(key[i]); }
        INV[(size_t)(b * SEQ + t) * NE + e] = slot;
    }
    __syncthreads();
}

__device__ __forceinline__ void phase_final(const Args& a, const Ctx& F, float* xdst) {
    unsigned char* ws = a.ws; const float* mod = (const float*)(ws + WS_MOD);
    const int gw = F.vcu * NWAVES + F.wave, NGW = F.G * NWAVES;
    const bf16_t* YEXP = (const bf16_t*)(ws + WS_YEXP); const int* INV = (const int*)(ws + WS_INV);
    int nslot = gw < MROWS ? INV[(size_t)gw * NE + (F.lane & 15)] : -1;
    for (int m = gw; m < MROWS; m += NGW) {
        const int b = m >> 13; const int slotv = nslot;
        if (m + NGW < MROWS) nslot = INV[(size_t)(m + NGW) * NE + (F.lane & 15)];
        f32x4* xr = (f32x4*)(a.out + (size_t)m * D) + F.lane;
        f32x4 xv[4];
#pragma unroll
        for (int j = 0; j < 4; ++j) xv[j] = xr[64 * j];
        unsigned bal = (unsigned)__ballot(slotv >= 0) & 0xFFFFu;
        f32x4 mo[4];
#pragma unroll
        for (int j = 0; j < 4; ++j) mo[j] = (f32x4){0.f, 0.f, 0.f, 0.f};
        while (bal) {
            int ee[4]; bool on[4];
#pragma unroll
            for (int q = 0; q < 4; ++q) { on[q] = bal != 0u; ee[q] = on[q] ? __builtin_ctz(bal) : ee[0]; bal = on[q] ? (bal & (bal - 1u)) : bal; }
            unsigned long long w[4][4];
#pragma unroll
            for (int q = 0; q < 4; ++q) { const int slot = __builtin_amdgcn_readlane(slotv, ee[q]); const unsigned long long* yr = (const unsigned long long*)(YEXP + ((size_t)((b * 16 + ee[q]) * CAP + slot)) * D) + F.lane;
#pragma unroll
                for (int j = 0; j < 4; ++j) w[q][j] = yr[64 * j]; }
#pragma unroll
            for (int q = 0; q < 4; ++q) if (on[q]) {
#pragma unroll
                for (int j = 0; j < 4; ++j) { const unsigned lo = (unsigned)w[q][j], hi = (unsigned)(w[q][j] >> 32); mo[j].x += bf_lo(lo); mo[j].y += bf_hi(lo); mo[j].z += bf_lo(hi); mo[j].w += bf_hi(hi); } }
        }
        const float* g2 = mod + b * 6144 + 5120;
        f32x4 v[4]; float s = 0.f;
#pragma unroll
        for (int j = 0; j < 4; ++j) { const f32x4 gv = ((const f32x4*)g2)[F.lane + 64 * j]; v[j] = xv[j] * ALPHA + gv * mo[j]; s += (v[j].x + v[j].y) + (v[j].z + v[j].w); }
        const float mean = wave_sum(s) * (1.f / D); float s2 = 0.f;
#pragma unroll
        for (int j = 0; j < 4; ++j) { v[j] = v[j] - mean; s2 += (v[j].x * v[j].x + v[j].y * v[j].y) + (v[j].z * v[j].z + v[j].w * v[j].w); }
        const float rstd = 1.f / sqrtf(wave_sum(s2) * (1.f / D) + LN_EPS);
#pragma unroll
        for (int j = 0; j < 4; ++j) { const f32x4 gv = ((const f32x4*)a.ln2_g)[F.lane + 64 * j], bv = ((const f32x4*)a.ln2_b)[F.lane + 64 * j]; ((f32x4*)(xdst + (size_t)m * D) + F.lane)[64 * j] = v[j] * rstd * gv + bv; }
    }
}

__global__ void __launch_bounds__(NWAVES * 64, 2) dit_fwd(Args args) {
    extern __shared__ __attribute__((aligned(16))) unsigned char lds[];
    Ctx F;
    F.lds = (LAS unsigned char*)lds;
    F.tid = threadIdx.x; F.lane = F.tid & 63; F.wave = __builtin_amdgcn_readfirstlane(F.tid >> 6);
    F.G = gridDim.x; { const int bx = blockIdx.x; F.vcu = (F.G % 8 == 0) ? (bx % 8) * (F.G / 8) + bx / 8 : bx; }
    volatile LAS unsigned* MISC = (volatile LAS unsigned*)(F.lds + MISC_OFF);
    unsigned char* ws = args.ws;
    gu32* ctl = (gu32*)(ws + WS_CTL);
    for (int u = F.tid; u < (LDS_BYTES - LDSCTL_OFF) / 4; u += NWAVES * 64) ((LAS unsigned*)(F.lds + LDSCTL_OFF))[u] = 0u;
    __syncthreads();
    XcdBarrier bar; bar.bar = (unsigned*)(ctl + CW_BAR); bar.x = 0; bar.st = nullptr;
    if (N_LAUNCHES == 1) bar = xcd_barrier_post((unsigned*)(ctl + CW_BAR), MISC + 8);
    const int lo = args.ph_lo, hi = args.ph_hi;
#ifndef PH_MASK
#define PH_MASK 0xFFFFF
#endif
#define IN(k) (((PH_MASK >> (k)) & 1) && lo <= (k) && (k) < hi)
#ifndef REP_MASK
#define REP_MASK 0
#endif
#ifndef BAR_REPS
#define BAR_REPS 1
#endif
#define REPS(k) (((REP_MASK >> (k)) & 1) ? 2 : 1)
#define SEAM(k) do { if (IN(k) && IN((k) + 1)) { for (int _b = 0; _b < BAR_REPS; ++_b) xcd_barrier(bar); } } while (0)
#define RSEAM(k, rep) do { if (N_LAUNCHES == 1 && (rep) + 1 < REPS(k)) xcd_barrier(bar); } while (0)
    const int G = F.G, cb = (int)blockIdx.x;

#define PH_BODY_0 phase0(args, F);
    if (IN(0)) { { PH_BODY_0 } if (REPS(0) == 2) { RSEAM(0, 0); { PH_BODY_0 } } } SEAM(0);
#define PH_BODY_1 phase1(args, F);
    if (IN(1)) { { PH_BODY_1 } if (REPS(1) == 2) { RSEAM(1, 0); { PH_BODY_1 } } } SEAM(1);
#define PH_BODY_2 PInProj p{(const bf16_t*)(ws + WS_XM), (const bf16_t*)(ws + WS_WINT), (bf16_t*)(ws + WS_AG), (bf16_t*)(ws + WS_ZG), G, cb}; pg8::gemm_phase(F.lds + RING_OFF, p);
    if (IN(2)) { { PH_BODY_2 } if (REPS(2) == 2) { RSEAM(2, 0); { PH_BODY_2 } } } SEAM(2);
#define PH_BODY_3 \
        { PLoc p{(const bf16_t*)(ws + WS_AG), (const bf16_t*)(ws + WS_BTG), (float*)(ws + WS_LOC), G, cb}; pg8::gemm_phase(F.lds + RING_OFF, p); } \
        __syncthreads(); \
         \
        { const int nun = MROWS / 128 * NHEAD; const int heavy = 48 < G ? 48 : 0; const int light = G - heavy; \
          if (cb >= heavy) gmlp_units(args, F, cb - heavy, nun - heavy, light); \
          else gmlp_units(args, F, nun - heavy + cb, nun - heavy + cb + 1, 1); } \

    if (IN(3)) { { PH_BODY_3 } if (REPS(3) == 2) { RSEAM(3, 0); { PH_BODY_3 } } } SEAM(3);
#define PH_BODY_4 phase_scan(args, F);
    if (IN(4)) { { PH_BODY_4 } if (REPS(4) == 2) { RSEAM(4, 0); { PH_BODY_4 } } } SEAM(4);
#define PH_BODY_5 PS5Main p{(const bf16_t*)(ws + WS_AG), (const bf16_t*)(ws + WS_BTG), (bf16_t*)(ws + WS_GY), G, cb}; pg8::gemm_phase(F.lds + RING_OFF, p);
    if (IN(5)) { { PH_BODY_5 } if (REPS(5) == 2) { RSEAM(5, 0); { PH_BODY_5 } } } SEAM(5);
#define PH_BODY_6 PGlu p{(const bf16_t*)(ws + WS_GY), (const bf16_t*)(ws + WS_WGLUT), args.b_glu, (bf16_t*)(ws + WS_AOUT), G, cb}; pg8::gemm_phase(F.lds + RING_OFF, p);
    if (IN(6)) { { PH_BODY_6 } if (REPS(6) == 2) { RSEAM(6, 0); { PH_BODY_6 } } } SEAM(6);
#define PH_BODY_7 POutProj p{(const bf16_t*)(ws + WS_AOUT), (const bf16_t*)(ws + WS_WOUTT), args.x, (const float*)(ws + WS_MOD), args.out, G, cb}; pg8::gemm_phase(F.lds + RING_OFF, p);
    if (IN(7)) { { PH_BODY_7 } if (REPS(7) == 2) { RSEAM(7, 0); { PH_BODY_7 } } } SEAM(7);
#define PH_BODY_8 phase_ln1(args, F, args.out);
    if (IN(8)) { if (REPS(8) == 2) { phase_ln1(args, F, (float*)(ws + WS_HID)); RSEAM(8, 0); } { PH_BODY_8 } } SEAM(8);
#define PH_BODY_9 for (int u = F.vcu; u < NB * NE; u += F.G) topk_unit(args, F, u);
    if (IN(9)) { { PH_BODY_9 } if (REPS(9) == 2) { RSEAM(9, 0); { PH_BODY_9 } } } SEAM(9);
#define PH_BODY_10 PGateUp p{(const fp8_t*)(ws + WS_HF8), (const fp8_t*)(ws + WS_WGU), (const int*)(ws + WS_SEL), (fp8_t*)(ws + WS_HID), G, cb}; pg8::gemm_phase(F.lds + RING_OFF, p);
    if (IN(10)) { { PH_BODY_10 } if (REPS(10) == 2) { RSEAM(10, 0); { PH_BODY_10 } } } SEAM(10);
#define PH_BODY_11 PDown p{(const fp8_t*)(ws + WS_HID), (const fp8_t*)(ws + WS_WDN), (const float*)(ws + WS_GATE), (bf16_t*)(ws + WS_YEXP), G, cb}; pg8::gemm_phase(F.lds + RING_OFF, p);
    if (IN(11)) { { PH_BODY_11 } if (REPS(11) == 2) { RSEAM(11, 0); { PH_BODY_11 } } } SEAM(11);
    if (IN(12)) { if (REPS(12) == 2) { phase_final(args, F, (float*)(ws + WS_HID)); RSEAM(12, 0); } phase_final(args, F, args.out); }
#undef IN
#undef SEAM
}

extern "C" void kernel_launch(void* const* d_in, const int* in_sizes, int n_in, void* d_out, int out_size, void* d_ws, size_t ws_size, hipStream_t stream) {
    static int grid = 0;
    if (grid == 0) {
        if (n_in != 28 || in_sizes[0] != MROWS * D || out_size != MROWS * D || ws_size < WS_END) {
            fprintf(stderr, "kernel_launch: built for 28 inputs, x/out of %d floats, >= %zu bytes of workspace; got n_in %d, in0 %d, out %d, ws %zu; nothing launched\n", MROWS * D, (size_t)WS_END, n_in, n_in > 0 ? in_sizes[0] : -1, out_size, ws_size);
            grid = -1; return; }
        int dev = 0, cus = 0, per_cu = 0;
        if (hipGetDevice(&dev) != hipSuccess || hipDeviceGetAttribute(&cus, hipDeviceAttributeMultiprocessorCount, dev) != hipSuccess) { fprintf(stderr, "kernel_launch: device query failed\n"); grid = -1; return; }
        if (hipFuncSetAttribute((const void*)dit_fwd, hipFuncAttributeMaxDynamicSharedMemorySize, LDS_BYTES) != hipSuccess) { fprintf(stderr, "kernel_launch: hipFuncSetAttribute failed\n"); grid = -1; return; }
        if (hipOccupancyMaxActiveBlocksPerMultiprocessor(&per_cu, (const void*)dit_fwd, NWAVES * 64, LDS_BYTES) != hipSuccess || per_cu < 1)
            fprintf(stderr, "kernel_launch: note: occupancy query reports %d workgroups per CU\n", per_cu);
        (void)hipGetLastError();
        grid = cus;
    }
    if (grid < 0) return;
    if (hipMemsetAsync((char*)d_ws + WS_CTL, 0, CTL_ZERO_BYTES, stream) != hipSuccess) { fprintf(stderr, "kernel_launch: hipMemsetAsync failed\n"); return; }
    Args a{};
    const float** ap = (const float**)&a;
    for (int i = 0; i < 28; ++i) ap[i] = (const float*)d_in[i];
    a.out = (float*)d_out; a.ws = (unsigned char*)d_ws;
    for (int li = 0; li < N_LAUNCHES; ++li) {
        a.ph_lo = (N_LAUNCHES == 1) ? 0 : li; a.ph_hi = (N_LAUNCHES == 1) ? NPH : li + 1;
        hipLaunchKernelGGL(dit_fwd, dim3(grid), dim3(NWAVES * 64), LDS_BYTES, stream, a);
        const hipError_t le = hipPeekAtLastError();
        if (le != hipSuccess) { fprintf(stderr, "kernel_launch: launch %d failed: %s\n", li, hipGetErrorName(le)); break; }
    }
}
```

```cpp
#include <hip/hip_runtime.h>
#include <cstdio>
#include <cstdint>

#ifndef MK_N_LAUNCHES
#define MK_N_LAUNCHES 1
#endif

namespace pg8 {
#define PG8_LAS __attribute__((address_space(3)))
typedef unsigned short bf16_t;
typedef short bf16x8 __attribute__((ext_vector_type(8)));
typedef float f32x4 __attribute__((ext_vector_type(4)));
typedef float f32x2 __attribute__((ext_vector_type(2)));
typedef unsigned u32x4 __attribute__((ext_vector_type(4)));
typedef unsigned u32x2 __attribute__((ext_vector_type(2)));
typedef int v4i32 __attribute__((ext_vector_type(4)));
typedef int v8i32 __attribute__((ext_vector_type(8)));
constexpr int BM = 256, BK = 64, HALF = 128, HTB = HALF * BK * 2  , STAGE_BYTES = 8 * HTB, NXCD = 8, WGM = 8;

__host__ __device__ __forceinline__ int lds_byte(int r, int c) { const int st = (r >> 4) * 2 + (c >> 5), rr = r & 15, cc = c & 31, ob = rr * 64 + cc * 2; return st * 1024 + (ob ^ (((ob >> 9) & 1) << 5)); }
__host__ __device__ __forceinline__ void stage_rc(int b, int& R, int& C) { const int st = b / 1024, sb = b % 1024, swz = sb ^ (((sb >> 9) & 1) << 5); R = (st >> 1) * 16 + swz / 64; C = (st & 1) * 32 + (swz % 64) / 2; }
__host__ __device__ __forceinline__ int perm32(int rho) { const int n = rho >> 4, i = rho & 15; return 8 * (i >> 2) + 4 * n + (i & 3); }

struct Unit { int pm, pn, z; };

__device__ __forceinline__ void tile_order(int L, int nM, int nN, int& pm, int& pn) {
    const int nwg = nM * nN; int wgid = L;
    { const int q = nwg / NXCD, r = nwg % NXCD, xcd = wgid % NXCD, off = wgid / NXCD; wgid = (xcd < r ? xcd * (q + 1) : r * (q + 1) + (xcd - r) * q) + off; }
    const int nig = WGM * nN, gid = wgid / nig, fm = gid * WGM, gsz = (nM - fm) < WGM ? (nM - fm) : WGM;
    pm = fm + ((wgid % nig) % gsz); pn = (wgid % nig) / gsz;
}

__device__ __forceinline__ unsigned cvt_pk_bf16(float lo, float hi) { unsigned r; asm volatile("v_cvt_pk_bf16_f32 %0, %1, %2" : "=v"(r) : "v"(lo), "v"(hi)); return r; }
__device__ __forceinline__ float bf_lo(unsigned w) { return __uint_as_float(w << 16); }
__device__ __forceinline__ float bf_hi(unsigned w) { return __uint_as_float(w & 0xffff0000u); }
__device__ __forceinline__ float fast_sigmoid(float x) { return __builtin_amdgcn_rcpf(1.0f + __builtin_amdgcn_exp2f(-1.44269504f * x)); }
__device__ __forceinline__ float gelu_tanh(float x) { const float u = x * (1.0f + 0.044715f * x * x) * 1.5957691216f; return x * fast_sigmoid(u); }

template <class P>
__device__ __forceinline__ void gemm_phase(PG8_LAS unsigned char* lds, const P& p) {
    const int tid = threadIdx.x, wid = __builtin_amdgcn_readfirstlane(tid >> 6), lane = tid & 63, wr = wid >> 2, wc = wid & 3, fr = lane & 15, fq = lane >> 4;
    constexpr int ESZ = P::FP8 ? 1 : 2;
    constexpr int K = P::K, nt = K * ESZ / 128, lda = P::LDA * ESZ, ldb = P::LDB * ESZ;
    static_assert((K * ESZ) % 256 == 0 && nt >= 4, "K bytes multiple of 256, >= 512");
    int Rr[2], Cc[2]; unsigned voB[2];
#pragma unroll
    for (int i = 0; i < 2; ++i) { int R, C; stage_rc(tid * 16 + i * 8192, R, C); Rr[i] = R; Cc[i] = C; const int Rb = P::PERM ? ((R & ~31) + perm32(R & 31)) : R; voB[i] = (unsigned)(Rb * ldb + C * 2); }
    unsigned voA[2][2], nvoA[2][2];
#define PG8_SETVOA(v, u) do { _Pragma("unroll") for (int _h = 0; _h < 2; ++_h) _Pragma("unroll") for (int _i = 0; _i < 2; ++_i) { const int _r = _h * HALF + Rr[_i]; \
        unsigned _row; if constexpr (P::GATHER) _row = (unsigned)p.a_row(u, _r); else _row = (unsigned)_r; v[_h][_i] = _row * (unsigned)lda + (unsigned)Cc[_i] * 2u; } } while (0)
    const size_t kstep = (size_t)(BK * 2);
    const size_t hstepB = (size_t)HALF * ldb;
    const unsigned ldsw = (unsigned)wid * 1024u;
    const int aoff = lds_byte(wr * 64 + fr, fq * 8), boff = lds_byte(wc * 32 + fr, fq * 8);
#define PG8_SA(b, h) (((b) * 2 + (h)) * HTB)
#define PG8_SB(b, h) ((4 + (b) * 2 + (h)) * HTB)
#define PG8_STAGE(bufoff, gbase, v0, v1) do { \
        __builtin_amdgcn_global_load_lds((const unsigned*)((const char*)(gbase) + (v0)), (PG8_LAS unsigned*)(lds + (bufoff) + ldsw), 16, 0, 0); \
        __builtin_amdgcn_global_load_lds((const unsigned*)((const char*)(gbase) + (v1)), (PG8_LAS unsigned*)(lds + (bufoff) + ldsw + 8192), 16, 0, 0); } while (0)
#define PG8_STAGE_A(bufoff, gbase, V, h) PG8_STAGE(bufoff, gbase, V[h][0], V[h][1])
#define PG8_STAGE_B(bufoff, gbase) PG8_STAGE(bufoff, gbase, voB[0], voB[1])
#define PG8_LDA(dst, b, h) do { _Pragma("unroll") for (int m = 0; m < 4; ++m) { dst[m].lo = *(const PG8_LAS v4i32*)(lds + PG8_SA(b, h) + aoff + m * 2048); dst[m].hi = *(const PG8_LAS v4i32*)(lds + PG8_SA(b, h) + aoff + m * 2048 + 1024); } } while (0)
#define PG8_LDB(dst, b, h) do { _Pragma("unroll") for (int n = 0; n < 2; ++n) { dst[n].lo = *(const PG8_LAS v4i32*)(lds + PG8_SB(b, h) + boff + n * 2048); dst[n].hi = *(const PG8_LAS v4i32*)(lds + PG8_SB(b, h) + boff + n * 2048 + 1024); } } while (0)
#define PG8_MMA(ai, bj, At, Bt) do { __builtin_amdgcn_s_setprio(1); _Pragma("unroll") for (int m = 0; m < 4; ++m) _Pragma("unroll") for (int n = 0; n < 2; ++n) { \
        if constexpr (P::FP8) {   \
            asm volatile("v_mfma_scale_f32_16x16x128_f8f6f4 %0, %1, %2, %0, %3, %4 op_sel_hi:[0,0,0]" : "+v"(acc[ai][bj][m][n]) : "v"(Bt[n]), "v"(At[m]), "v"(sclW), "v"(sclA));   \
        } else { const v4i32 _bl = Bt[n].lo, _bh = Bt[n].hi, _al = At[m].lo, _ah = At[m].hi;     \
                 acc[ai][bj][m][n] = __builtin_amdgcn_mfma_f32_16x16x32_bf16(__builtin_bit_cast(bf16x8, _bl), __builtin_bit_cast(bf16x8, _al), acc[ai][bj][m][n], 0, 0, 0); \
                 acc[ai][bj][m][n] = __builtin_amdgcn_mfma_f32_16x16x32_bf16(__builtin_bit_cast(bf16x8, _bh), __builtin_bit_cast(bf16x8, _ah), acc[ai][bj][m][n], 0, 0, 0); } } \
        __builtin_amdgcn_s_setprio(0); } while (0)
#define PG8_WAIT_V(n) asm volatile("s_waitcnt vmcnt(" #n ")" ::: "memory")
#define PG8_WAIT_L(n) asm volatile("s_waitcnt lgkmcnt(" #n ")" ::: "memory")
#define PG8_BAR __builtin_amdgcn_s_barrier()
#define PG8_SCHED __builtin_amdgcn_sched_barrier(0)
    Unit cur, nxt; int ui = 0;
    if (!p.next(0, cur)) return;
    f32x4 acc[2][2][4][2];
#pragma unroll
    for (int a = 0; a < 2; ++a)
#pragma unroll
        for (int b = 0; b < 2; ++b)
#pragma unroll
            for (int m = 0; m < 4; ++m)
#pragma unroll
                for (int n = 0; n < 2; ++n) acc[a][b][m][n] = (f32x4){0.f, 0.f, 0.f, 0.f};
    v8i32 At[4], B0[2], B1[2];
    int sclW = 0x7F7F7F7F, sclA = 0x7F7F7F7F; if constexpr (P::FP8) sclW = P::SCALE_W;
    asm volatile("" : "+v"(sclW), "+v"(sclA));
    const char* cA = (const char*)p.a_base(cur); const char* cB = (const char*)p.b_base(cur);
    PG8_SETVOA(voA, cur);
    PG8_STAGE_B(PG8_SB(0, 0), cB); PG8_STAGE_B(PG8_SB(0, 1), cB + hstepB); PG8_STAGE_A(PG8_SA(0, 0), cA, voA, 0); PG8_STAGE_A(PG8_SA(0, 1), cA, voA, 1);
    if (wr == 1) PG8_BAR;
    PG8_WAIT_V(2); PG8_BAR;
    PG8_STAGE_B(PG8_SB(1, 0), cB + kstep); PG8_STAGE_A(PG8_SA(1, 0), cA + kstep, voA, 0); PG8_STAGE_B(PG8_SB(1, 1), cB + hstepB + kstep);
    PG8_WAIT_V(6); PG8_BAR;
    for (;;) {
        const bool has_next = p.next(ui + 1, nxt);
        const char* nA = has_next ? (const char*)p.a_base(nxt) : cA; const char* nB = has_next ? (const char*)p.b_base(nxt) : cB;
        if constexpr (P::GATHER) {
            if (has_next) PG8_SETVOA(nvoA, nxt);
            else {
#pragma unroll
                for (int h = 0; h < 2; ++h)
#pragma unroll
                    for (int i = 0; i < 2; ++i) nvoA[h][i] = voA[h][i]; }
        }
#pragma nounroll
        for (int t = 0; t < nt; t += 2) {
            const bool last = (t == nt - 2);
            const char* a1 = cA + (size_t)(t + 1) * kstep;
            const char* a2 = last ? nA : cA + (size_t)(t + 2) * kstep; const char* b2 = last ? nB : cB + (size_t)(t + 2) * kstep;
            const char* a3 = a2 + kstep; const char* b3 = b2 + kstep;
            unsigned wA[2][2];
#pragma unroll
            for (int h = 0; h < 2; ++h)
#pragma unroll
                for (int i = 0; i < 2; ++i) { if constexpr (P::GATHER) wA[h][i] = last ? nvoA[h][i] : voA[h][i]; else wA[h][i] = voA[h][i]; }
            PG8_LDB(B0, 0, 0); PG8_LDB(B1, 0, 1); PG8_SCHED; PG8_LDA(At, 0, 0); PG8_STAGE_A(PG8_SA(1, 1), a1, voA, 1);
            PG8_WAIT_V(8); PG8_WAIT_L(0); PG8_BAR; PG8_MMA(0, 0, At, B0); PG8_MMA(0, 1, At, B1); PG8_BAR; PG8_SCHED;
            PG8_LDA(At, 0, 1); PG8_STAGE_B(PG8_SB(0, 0), b2); PG8_STAGE_B(PG8_SB(0, 1), b2 + hstepB); PG8_STAGE_A(PG8_SA(0, 0), a2, wA, 0);
            PG8_WAIT_V(8); PG8_WAIT_L(0); PG8_BAR; PG8_MMA(1, 0, At, B0); PG8_MMA(1, 1, At, B1); PG8_BAR; PG8_SCHED;
            PG8_LDB(B0, 1, 0); PG8_LDB(B1, 1, 1); PG8_SCHED; PG8_LDA(At, 1, 0); PG8_STAGE_A(PG8_SA(0, 1), a2, wA, 1);
            PG8_WAIT_V(8); PG8_WAIT_L(0); PG8_BAR; PG8_MMA(0, 0, At, B0); PG8_MMA(0, 1, At, B1); PG8_BAR; PG8_SCHED;
            PG8_LDA(At, 1, 1); PG8_STAGE_B(PG8_SB(1, 0), b3); PG8_STAGE_B(PG8_SB(1, 1), b3 + hstepB); PG8_STAGE_A(PG8_SA(1, 0), a3, wA, 0);
            PG8_WAIT_V(8); PG8_WAIT_L(0); PG8_BAR; PG8_MMA(1, 0, At, B0); PG8_MMA(1, 1, At, B1); PG8_BAR; PG8_SCHED;
        }
        if constexpr (P::FP8) asm volatile("s_nop 15\n\ts_nop 15" ::: "memory");
        if (wr == 0) PG8_BAR;
        p.epi(acc, cur, wr, wc, fr, fq);
        if (!has_next) break;
#pragma unroll
        for (int a = 0; a < 2; ++a)
#pragma unroll
            for (int b = 0; b < 2; ++b)
#pragma unroll
                for (int m = 0; m < 4; ++m)
#pragma unroll
                    for (int n = 0; n < 2; ++n) acc[a][b][m][n] = (f32x4){0.f, 0.f, 0.f, 0.f};
        cur = nxt; cA = nA; cB = nB; ++ui;
        if constexpr (P::GATHER) {
#pragma unroll
            for (int h = 0; h < 2; ++h)
#pragma unroll
                for (int i = 0; i < 2; ++i) voA[h][i] = nvoA[h][i]; }
        if (wr == 1) PG8_BAR;
    }
    PG8_WAIT_V(0);
    PG8_BAR;
#undef PG8_SETVOA
#undef PG8_SA
#undef PG8_SB
#undef PG8_STAGE
#undef PG8_STAGE_A
#undef PG8_STAGE_B
#undef PG8_LDA
#undef PG8_LDB
#undef PG8_MMA
#undef PG8_WAIT_V
#undef PG8_WAIT_L
#undef PG8_BAR
#undef PG8_SCHED
}
}
using pg8::bf16_t; using pg8::f32x4; using pg8::f32x2; using pg8::u32x4; using pg8::u32x2; using pg8::bf16x8; using pg8::Unit;
using pg8::cvt_pk_bf16; using pg8::bf_lo; using pg8::bf_hi; using pg8::gelu_tanh; using pg8::fast_sigmoid;

constexpr int NWAVES = 8;
constexpr int D = 1024, NB = 4, SEQ = 8192, CTXL = 256;
constexpr int MROWS = NB * SEQ, CROWS = NB * CTXL, XROWS = MROWS + CROWS;
constexpr int S5W = 256, GMW = 768, INC = 1792, NE = 16, CAP = 1024, DFF = 2816, NHEAD = 6;
constexpr int TCH = 64, NCL = MROWS / TCH, NCC = CROWS / TCH;
constexpr int AG_ROWS = 768, AG_LD = 1280, BT_LD = 1280;
constexpr float ALPHA = 1.189207115f;
constexpr float LN_EPS = 1e-6f;
constexpr int NPH = 13;
constexpr int N_LAUNCHES = MK_N_LAUNCHES;
static_assert(N_LAUNCHES == 1 || N_LAUNCHES == NPH, "MK_N_LAUNCHES is 1 or NPH");

constexpr size_t MiB = 1u << 20;
constexpr size_t WS_CTL = 0, CTL_ZERO_BYTES = 64 * 1024;
constexpr size_t WS_MOD = 1 * MiB;
constexpr size_t WS_PAR = 1 * MiB + 256 * 1024;
constexpr size_t WS_WINT = 2 * MiB;
constexpr size_t WS_WOUTT = 6 * MiB;
constexpr size_t WS_WGLUT = 8 * MiB;
constexpr size_t WS_WSGM = 8 * MiB + 256 * 1024;
constexpr size_t WS_SEL = 9 * MiB;
constexpr size_t WS_GATE = 9 * MiB + 512 * 1024;
constexpr size_t WS_AFF = 10 * MiB;
constexpr size_t WS_INV = 12 * MiB;
constexpr size_t WS_KTAB = 14 * MiB;
constexpr size_t WS_HF8 = 16 * MiB;
constexpr size_t WS_WGU = 48 * MiB;
constexpr size_t WS_WDN = 136 * MiB;
constexpr size_t WS_BIG = 180 * MiB;
constexpr size_t WS_HID = WS_BIG;
constexpr size_t WS_YEXP = WS_BIG + 176 * MiB;
constexpr size_t WS_XM = WS_BIG;
constexpr size_t WS_ZG = WS_BIG + 66 * MiB;
constexpr size_t WS_AG = WS_BIG + 162 * MiB;
constexpr size_t WS_BTG = WS_BIG + 192 * MiB;
constexpr size_t WS_LOC = WS_BIG + 242 * MiB;
constexpr size_t WS_GY = WS_BIG + 254 * MiB;
constexpr size_t WS_AOUT = WS_BIG + 270 * MiB;
constexpr size_t WS_END = WS_BIG + 334 * MiB;
static_assert(WS_AOUT + 64 * MiB <= WS_END && WS_YEXP + 128 * MiB <= WS_END, "overlays inside the temporaries region");
constexpr int CW_BAR = 1024;

constexpr int RING_OFF = 0, RING_BYTES = 131072;
constexpr int LDSCTL_OFF = RING_BYTES, MISC_OFF = LDSCTL_OFF + 320;
constexpr int LDS_BYTES = 147456;

#define GAS __attribute__((address_space(1)))
#define LAS __attribute__((address_space(3)))
typedef GAS unsigned gu32;
#define RLX_AGENT __ATOMIC_RELAXED, __HIP_MEMORY_SCOPE_AGENT
#define LDS_WAIT() asm volatile("s_waitcnt lgkmcnt(0)" ::: "memory")
__device__ __forceinline__ unsigned f2bf(float f) { unsigned u = __builtin_bit_cast(unsigned, f); return (u + 0x7fffu + ((u >> 16) & 1u)) >> 16; }
__device__ __forceinline__ unsigned pk2(float lo, float hi) { return f2bf(lo) | (f2bf(hi) << 16); }
typedef unsigned char fp8_t;
__device__ __forceinline__ unsigned pk4_fp8(float a, float b, float c, float d) {
    a = __builtin_amdgcn_fmed3f(a, -448.f, 448.f); b = __builtin_amdgcn_fmed3f(b, -448.f, 448.f); c = __builtin_amdgcn_fmed3f(c, -448.f, 448.f); d = __builtin_amdgcn_fmed3f(d, -448.f, 448.f);
    int w = 0; w = __builtin_amdgcn_cvt_pk_fp8_f32(a, b, w, false); w = __builtin_amdgcn_cvt_pk_fp8_f32(c, d, w, true); return (unsigned)w; }
__device__ __forceinline__ float wave_sum(float v) {
#pragma unroll
    for (int o = 1; o < 64; o <<= 1) v += __shfl_xor(v, o);
    return v;
}

#define XB_TMO      128
#define XB_XCNT(j)  (256  + 64 * (j))
#define XB_XSUB(j)  (1280 + 64 * (j))
#define XB_XGEN(j)  (2304 + 64 * (j))
#define XB_TOP      3328
#define XB_TOPGEN   3392
#define XCD_BAR_WORDS 3456
#define XB_SPIN_CAP (1u << 18)
__device__ __forceinline__ unsigned xb_ld(unsigned* p)              { return __hip_atomic_load(p, __ATOMIC_RELAXED, __HIP_MEMORY_SCOPE_AGENT); }
__device__ __forceinline__ unsigned xb_add(unsigned* p, unsigned v) { return __hip_atomic_fetch_add(p, v, __ATOMIC_RELAXED, __HIP_MEMORY_SCOPE_AGENT); }
__device__ __forceinline__ unsigned xb_xcc_id() { return (unsigned)__builtin_amdgcn_s_getreg((3 << 11) | 20) & 0xFu; }
#define XB_SPIN(cond, bar) do { unsigned _sp = 0; while (cond) { __builtin_amdgcn_s_sleep(1); \
    if ((++_sp & 255u) == 0u) { if (xb_ld(&(bar)[XB_TMO])) break; if (_sp > XB_SPIN_CAP) { atomicAdd(&(bar)[XB_TMO], 1u); break; } } } } while (0)
struct XcdBarrier { unsigned* bar; unsigned x; volatile LAS unsigned* st; };
__device__ __forceinline__ XcdBarrier xcd_barrier_post(unsigned* bar, volatile LAS unsigned* st) {
    XcdBarrier b; b.bar = bar; b.x = xb_xcc_id(); b.st = st;
    if (threadIdx.x == 0) (void)xb_add(&bar[XB_XCNT(b.x)], 1u);
    return b;
}
__device__ __forceinline__ void xcd_barrier_complete(unsigned* bar, unsigned x, unsigned& nloc, unsigned& nx) {
    const unsigned G = gridDim.x * gridDim.y * gridDim.z;
    unsigned sum, cnt, mine, sp = 0u;
    for (;;) {
        sum = 0u; cnt = 0u; mine = 0u;
#pragma unroll
        for (unsigned j = 0; j < 16; ++j) { const unsigned c = xb_ld(&bar[XB_XCNT(j)]); sum += c; cnt += (c > 0u) ? 1u : 0u; mine = (j == x) ? c : mine; }
        if (sum == G) break;
        __builtin_amdgcn_s_sleep(1);
        if ((++sp & 255u) == 0u) { if (xb_ld(&bar[XB_TMO])) break; if (sp > XB_SPIN_CAP) { atomicAdd(&bar[XB_TMO], 1u); break; } }
    }
    nloc = mine > 0u ? mine : 1u; nx = cnt > 0u ? cnt : 1u;
}
__device__ __forceinline__ void xcd_barrier(const XcdBarrier& b) {
    asm volatile("s_waitcnt vmcnt(0)" ::: "memory");
    __syncthreads();
    if (threadIdx.x == 0) {
        unsigned* bar = b.bar;
        __builtin_amdgcn_s_waitcnt(0);
        unsigned nloc = b.st[0], nx = b.st[1];
        if (nloc == 0u) { xcd_barrier_complete(bar, b.x, nloc, nx); b.st[0] = nloc; b.st[1] = nx; }
        const unsigned old = xb_add(&bar[XB_XSUB(b.x)], 1u);
        const unsigned gen = old / nloc;
        if (old + 1u == (gen + 1u) * nloc) {
            __builtin_amdgcn_fence(__ATOMIC_RELEASE, "agent");
            asm volatile("s_waitcnt vmcnt(0)" ::: "memory");
            const unsigned og = xb_add(&bar[XB_TOP], 1u);
            const unsigned tg = og / nx;
            if (og + 1u == (tg + 1u) * nx) xb_add(&bar[XB_TOPGEN], 1u);
            else XB_SPIN(xb_ld(&bar[XB_TOPGEN]) == tg, bar);
            __builtin_amdgcn_fence(__ATOMIC_ACQUIRE, "agent");
            xb_add(&bar[XB_XGEN(b.x)], 1u);
            asm volatile("s_waitcnt vmcnt(0)" ::: "memory");
        } else {
            XB_SPIN(xb_ld(&bar[XB_XGEN(b.x)]) == gen, bar);
            __builtin_amdgcn_fence(__ATOMIC_ACQUIRE, "agent");
            asm volatile("s_waitcnt vmcnt(0)" ::: "memory");
        }
    }
    __syncthreads();
}

struct Args {
    const float *x, *c, *ctx, *c_ctx, *w_ada, *b_ada, *w_in, *gm_ws, *gm_bs, *a_re, *a_im, *log_step, *b_re, *b_im, *c_re, *c_im, *s5_d, *w_glu, *b_glu, *w_out,
                *ln1_g, *ln1_b, *w_router, *w_gate, *w_up, *w_down, *ln2_g, *ln2_b;
    float* out; unsigned char* ws; int ph_lo, ph_hi;
};

struct PInProj {
    static constexpr bool PERM = true, GATHER = false, FP8 = false; static constexpr int K = D, LDA = D, LDB = D;
    const bf16_t* A; const bf16_t* Bt; bf16_t* AG; bf16_t* ZG; int G, c;
    __device__ __forceinline__ bool next(int i, Unit& u) const { const int L = i * G + c; if (L >= 900) return false; if (L < 4) { u.pm = 128 + L; u.pn = 0; } else pg8::tile_order(L - 4, 128, 7, u.pm, u.pn); u.z = 0; return true; }
    __device__ __forceinline__ const bf16_t* a_base(const Unit& u) const { return A + (size_t)u.pm * 256 * D; }
    __device__ __forceinline__ const bf16_t* b_base(const Unit& u) const { return Bt + (size_t)u.pn * 256 * D; }
    __device__ __forceinline__ int a_row(const Unit&, int r) const { return r; }
    __device__ __forceinline__ void epi(const f32x4 (&acc)[2][2][4][2], const Unit& u, int wr, int wc, int fr, int fq) const {
        const int row0 = u.pm * 256 + wr * 64 + fr;
        if (u.pn == 0) {
#pragma unroll
            for (int ai = 0; ai < 2; ++ai)
#pragma unroll
                for (int m = 0; m < 4; ++m) { const int row = row0 + ai * 128 + m * 16; const int chunk = row < MROWS ? (row >> 6) : (NCL + ((row - MROWS) >> 6)); const int ti = row & 63;
#pragma unroll
                    for (int bj = 0; bj < 2; ++bj) { const int c0 = bj * 128 + wc * 32 + 8 * fq, g = c0 >> 4, h0 = c0 & 15; const f32x4 v0 = acc[ai][bj][m][0], v1 = acc[ai][bj][m][1];
                        u32x4 w; w.x = cvt_pk_bf16(v0[0], v0[1]); w.y = cvt_pk_bf16(v0[2], v0[3]); w.z = cvt_pk_bf16(v1[0], v1[1]); w.w = cvt_pk_bf16(v1[2], v1[3]);
                        *(u32x4*)(AG + ((size_t)(g * AG_ROWS + chunk) * AG_LD + ti * 16 + h0)) = w; } }
        } else {
            const int col0 = (u.pn - 1) * 256 + wc * 32 + 8 * fq;
#pragma unroll
            for (int ai = 0; ai < 2; ++ai)
#pragma unroll
                for (int m = 0; m < 4; ++m) { bf16_t* rowp = ZG + (size_t)(row0 + ai * 128 + m * 16) * 1536 + col0;
#pragma unroll
                    for (int bj = 0; bj < 2; ++bj) { const f32x4 v0 = acc[ai][bj][m][0], v1 = acc[ai][bj][m][1];
                        u32x4 w; w.x = cvt_pk_bf16(gelu_tanh(v0[0]), gelu_tanh(v0[1])); w.y = cvt_pk_bf16(gelu_tanh(v0[2]), gelu_tanh(v0[3]));
                        w.z = cvt_pk_bf16(gelu_tanh(v1[0]), gelu_tanh(v1[1])); w.w = cvt_pk_bf16(gelu_tanh(v1[2]), gelu_tanh(v1[3]));
                        *(u32x4*)(rowp + bj * 128) = w; } }
        }
    }
};
struct PLoc {
    static constexpr bool PERM = false, GATHER = false, FP8 = false; static constexpr int K = 1024, LDA = AG_LD, LDB = BT_LD;
    const bf16_t* AG; const bf16_t* BTG; float* LOC; int G, c;
    __device__ __forceinline__ bool next(int i, Unit& u) const { const int L = i * G + c; if (L >= 48) return false; u.z = L / 3; u.pm = L % 3; u.pn = 0; return true; }
    __device__ __forceinline__ const bf16_t* a_base(const Unit& u) const { return AG + (size_t)(u.z * AG_ROWS + u.pm * 256) * AG_LD; }
    __device__ __forceinline__ const bf16_t* b_base(const Unit& u) const { return BTG + (size_t)(u.z * BT_LD + 1024) * BT_LD; }
    __device__ __forceinline__ int a_row(const Unit&, int r) const { return r; }
    __device__ __forceinline__ void epi(const f32x4 (&acc)[2][2][4][2], const Unit& u, int wr, int wc, int fr, int fq) const {
        const int row0 = u.pm * 256 + wr * 64 + fr, col0 = wc * 32 + 4 * fq;
#pragma unroll
        for (int ai = 0; ai < 2; ++ai)
#pragma unroll
            for (int m = 0; m < 4; ++m) { float* rowp = LOC + (size_t)(u.z * AG_ROWS + row0 + ai * 128 + m * 16) * 256 + col0;
#pragma unroll
                for (int bj = 0; bj < 2; ++bj)
#pragma unroll
                    for (int n = 0; n < 2; ++n) *(f32x4*)(rowp + bj * 128 + n * 16) = acc[ai][bj][m][n]; }
    }
};
struct PS5Main {
    static constexpr bool PERM = true, GATHER = false, FP8 = false; static constexpr int K = 1280, LDA = AG_LD, LDB = BT_LD;
    const bf16_t* AG; const bf16_t* BTG; bf16_t* GY; int G, c;
    __device__ __forceinline__ bool next(int i, Unit& u) const { const int L = i * G + c; if (L >= 128) return false; u.z = L >> 3; u.pm = (L >> 2) & 1; u.pn = L & 3; return true; }
    __device__ __forceinline__ const bf16_t* a_base(const Unit& u) const { return AG + (size_t)(u.z * AG_ROWS + u.pm * 256) * AG_LD; }
    __device__ __forceinline__ const bf16_t* b_base(const Unit& u) const { return BTG + (size_t)(u.z * BT_LD + u.pn * 256) * BT_LD; }
    __device__ __forceinline__ int a_row(const Unit&, int r) const { return r; }
    __device__ __forceinline__ void epi(const f32x4 (&acc)[2][2][4][2], const Unit& u, int wr, int wc, int fr, int fq) const {
        const int chunk0 = u.pm * 256 + wr * 64 + fr;
#pragma unroll
        for (int ai = 0; ai < 2; ++ai)
#pragma unroll
            for (int m = 0; m < 4; ++m) { const int chunk = chunk0 + ai * 128 + m * 16;
#pragma unroll
                for (int bj = 0; bj < 2; ++bj) { const int n0 = u.pn * 256 + bj * 128 + wc * 32 + 8 * fq, j = n0 >> 4, h0 = n0 & 15; const f32x4 v0 = acc[ai][bj][m][0], v1 = acc[ai][bj][m][1];
                    u32x4 w; w.x = cvt_pk_bf16(gelu_tanh(v0[0]), gelu_tanh(v0[1])); w.y = cvt_pk_bf16(gelu_tanh(v0[2]), gelu_tanh(v0[3]));
                    w.z = cvt_pk_bf16(gelu_tanh(v1[0]), gelu_tanh(v1[1])); w.w = cvt_pk_bf16(gelu_tanh(v1[2]), gelu_tanh(v1[3]));
                    *(u32x4*)(GY + ((size_t)(chunk * TCH + j) * S5W + u.z * 16 + h0)) = w; } }
    }
};
struct PGlu {
    static constexpr bool PERM = true, GATHER = false, FP8 = false; static constexpr int K = 256, LDA = 256, LDB = 256;
    const bf16_t* GY; const bf16_t* Bt; const float* b_glu; bf16_t* AOUT; int G, c;
    __device__ __forceinline__ bool next(int i, Unit& u) const { const int L = i * G + c; if (L >= 128) return false; u.pm = L; u.pn = 0; u.z = 0; return true; }
    __device__ __forceinline__ const bf16_t* a_base(const Unit& u) const { return GY + (size_t)u.pm * 256 * 256; }
    __device__ __forceinline__ const bf16_t* b_base(const Unit&) const { return Bt; }
    __device__ __forceinline__ int a_row(const Unit&, int r) const { return r; }
    __device__ __forceinline__ void epi(const f32x4 (&acc)[2][2][4][2], const Unit& u, int wr, int wc, int fr, int fq) const {
        const int row0 = u.pm * 256 + wr * 64 + fr, col0 = wc * 32 + 8 * fq;
        f32x4 bv[2][2];
#pragma unroll
        for (int bj = 0; bj < 2; ++bj)
#pragma unroll
            for (int n = 0; n < 2; ++n) bv[bj][n] = *(const f32x4*)(b_glu + col0 + bj * 128 + 4 * n);
#pragma unroll
        for (int ai = 0; ai < 2; ++ai)
#pragma unroll
            for (int m = 0; m < 4; ++m) { const int row = row0 + ai * 128 + m * 16;
#pragma unroll
                for (int bj = 0; bj < 2; ++bj) { const u32x4 gw = *(const u32x4*)(GY + (size_t)row * 256 + col0 + bj * 128);
                    const f32x4 v0 = acc[ai][bj][m][0] + bv[bj][0], v1 = acc[ai][bj][m][1] + bv[bj][1];
                    u32x4 w; w.x = cvt_pk_bf16(bf_lo(gw.x) * fast_sigmoid(v0[0]), bf_hi(gw.x) * fast_sigmoid(v0[1])); w.y = cvt_pk_bf16(bf_lo(gw.y) * fast_sigmoid(v0[2]), bf_hi(gw.y) * fast_sigmoid(v0[3]));
                    w.z = cvt_pk_bf16(bf_lo(gw.z) * fast_sigmoid(v1[0]), bf_hi(gw.z) * fast_sigmoid(v1[1])); w.w = cvt_pk_bf16(bf_lo(gw.w) * fast_sigmoid(v1[2]), bf_hi(gw.w) * fast_sigmoid(v1[3]));
                    *(u32x4*)(AOUT + (size_t)row * D + col0 + bj * 128) = w; }
                asm volatile("" ::: "memory"); }
    }
};
struct POutProj {
    static constexpr bool PERM = false, GATHER = false, FP8 = false; static constexpr int K = D, LDA = D, LDB = D;
    const bf16_t* A; const bf16_t* Bt; const float* x; const float* mod; float* Y; int G, c;
    __device__ __forceinline__ bool next(int i, Unit& u) const { const int L = i * G + c; if (L >= 512) return false; pg8::tile_order(L, 128, 4, u.pm, u.pn); u.z = 0; return true; }
    __device__ __forceinline__ const bf16_t* a_base(const Unit& u) const { return A + (size_t)u.pm * 256 * D; }
    __device__ __forceinline__ const bf16_t* b_base(const Unit& u) const { return Bt + (size_t)u.pn * 256 * D; }
    __device__ __forceinline__ int a_row(const Unit&, int r) const { return r; }
    __device__ __forceinline__ void epi(const f32x4 (&acc)[2][2][4][2], const Unit& u, int wr, int wc, int fr, int fq) const {
        const int row0 = u.pm * 256 + wr * 64 + fr, col0 = u.pn * 256 + wc * 32 + 4 * fq;
        const float* g1 = mod + (size_t)(u.pm >> 5) * 6144 + 2048;
        f32x4 gv[2][2];
#pragma unroll
        for (int bj = 0; bj < 2; ++bj)
#pragma unroll
            for (int n = 0; n < 2; ++n) gv[bj][n] = *(const f32x4*)(g1 + col0 + bj * 128 + n * 16);
#pragma unroll
        for (int ai = 0; ai < 2; ++ai)
#pragma unroll
            for (int m = 0; m < 4; ++m) { const size_t off = (size_t)(row0 + ai * 128 + m * 16) * D + col0;
#pragma unroll
                for (int bj = 0; bj < 2; ++bj)
#pragma unroll
                    for (int n = 0; n < 2; ++n) { const f32x4 xv = *(const f32x4*)(x + off + bj * 128 + n * 16); *(f32x4*)(Y + off + bj * 128 + n * 16) = xv * ALPHA + gv[bj][n] * acc[ai][bj][m][n]; }
                asm volatile("" ::: "memory"); }
    }
};
__device__ __forceinline__ void moe_tile(int pmx, int& e, int& rowbase) { e = pmx >> 4; const int b = (pmx >> 2) & 3, mt = pmx & 3; rowbase = (b * 16 + e) * CAP + mt * 256; }
constexpr float WGU_SCALE = 64.f, WDN_SCALE = 128.f;
struct PGateUp {
    static constexpr bool PERM = true, GATHER = true, FP8 = true; static constexpr int K = D, LDA = D, LDB = D, SCALE_W = 0x79797979;
    const fp8_t* HF8; const fp8_t* WGU; const int* SEL; fp8_t* HID; int G, c;
    __device__ __forceinline__ bool next(int i, Unit& u) const { const int L = i * G + c; if (L >= 256 * 22) return false; pg8::tile_order(L, 256, 22, u.pm, u.pn); int e, rb; moe_tile(u.pm, e, rb); u.z = rb; return true; }
    __device__ __forceinline__ const fp8_t* a_base(const Unit&) const { return HF8; }
    __device__ __forceinline__ const fp8_t* b_base(const Unit& u) const { return WGU + ((size_t)(u.pm >> 4) * 5632 + (size_t)u.pn * 256) * D; }
    __device__ __forceinline__ int a_row(const Unit& u, int r) const { return SEL[u.z + r]; }
    __device__ __forceinline__ void epi(const f32x4 (&acc)[2][2][4][2], const Unit& u, int wr, int wc, int fr, int fq) const {
        const int row0 = u.z + wr * 64 + fr, col0 = u.pn * 128 + wc * 32 + 8 * fq;
#pragma unroll
        for (int ai = 0; ai < 2; ++ai)
#pragma unroll
            for (int m = 0; m < 4; ++m) { fp8_t* rowp = HID + (size_t)(row0 + ai * 128 + m * 16) * DFF + col0;
                const f32x4 g0 = acc[ai][0][m][0], g1 = acc[ai][0][m][1], u0 = acc[ai][1][m][0], u1 = acc[ai][1][m][1];
                u32x2 w; w.x = pk4_fp8(g0[0] * fast_sigmoid(g0[0]) * u0[0], g0[1] * fast_sigmoid(g0[1]) * u0[1], g0[2] * fast_sigmoid(g0[2]) * u0[2], g0[3] * fast_sigmoid(g0[3]) * u0[3]);
                w.y = pk4_fp8(g1[0] * fast_sigmoid(g1[0]) * u1[0], g1[1] * fast_sigmoid(g1[1]) * u1[1], g1[2] * fast_sigmoid(g1[2]) * u1[2], g1[3] * fast_sigmoid(g1[3]) * u1[3]);
                *(u32x2*)rowp = w; }
    }
};
struct PDown {
    static constexpr bool PERM = true, GATHER = false, FP8 = true; static constexpr int K = DFF, LDA = DFF, LDB = DFF, SCALE_W = 0x78787878;
    const fp8_t* HID; const fp8_t* WDN; const float* GATE; bf16_t* YEXP; int G, c;
    __device__ __forceinline__ bool next(int i, Unit& u) const { const int L = i * G + c; if (L >= 256 * 4) return false; pg8::tile_order(L, 256, 4, u.pm, u.pn); int e, rb; moe_tile(u.pm, e, rb); u.z = rb; return true; }
    __device__ __forceinline__ const fp8_t* a_base(const Unit& u) const { return HID + (size_t)u.z * DFF; }
    __device__ __forceinline__ const fp8_t* b_base(const Unit& u) const { return WDN + ((size_t)(u.pm >> 4) * D + (size_t)u.pn * 256) * DFF; }
    __device__ __forceinline__ int a_row(const Unit&, int r) const { return r; }
    __device__ __forceinline__ void epi(const f32x4 (&acc)[2][2][4][2], const Unit& u, int wr, int wc, int fr, int fq) const {
        const int row0 = u.z + wr * 64 + fr, col0 = u.pn * 256 + wc * 32 + 8 * fq;
#pragma unroll
        for (int ai = 0; ai < 2; ++ai)
#pragma unroll
            for (int m = 0; m < 4; ++m) { const int row = row0 + ai * 128 + m * 16; const float gt = GATE[row]; bf16_t* rowp = YEXP + (size_t)row * D + col0;
#pragma unroll
                for (int bj = 0; bj < 2; ++bj) { const f32x4 v0 = acc[ai][bj][m][0] * gt, v1 = acc[ai][bj][m][1] * gt;
                    u32x4 w; w.x = cvt_pk_bf16(v0[0], v0[1]); w.y = cvt_pk_bf16(v0[2], v0[3]); w.z = cvt_pk_bf16(v1[0], v1[1]); w.w = cvt_pk_bf16(v1[2], v1[3]);
                    *(u32x4*)(rowp + bj * 128) = w; } }
    }
};

struct Ctx { LAS unsigned char* lds; int tid, lane, wave, vcu, G; };

__device__ __forceinline__ void s5_param(const Args& a, int d, int g, int p, float& lr, float& li, float& cbr, float& cbi) {
    const float step = expf(a.log_step[d * 16 + g]); const float ar = a.a_re[(d * 16 + g) * 64 + p], ai = a.a_im[(d * 16 + g) * 64 + p];
    lr = ar * step; li = ai * step;
    float s, c; sincosf(li, &s, &c);
    const float em1 = expm1f(lr), e = em1 + 1.0f; const float s2 = sinf(0.5f * li); const float cm1 = -2.0f * s2 * s2;
    const float nr = em1 * c + cm1, ni = e * s, den = ar * ar + ai * ai;
    cbr = (nr * ar + ni * ai) / den; cbi = (ni * ar - nr * ai) / den;
}
__device__ __forceinline__ void cpow(float lr, float li, float e, float& pr, float& pi) { const float m = expf(lr * e); float s, c; sincosf(li * e, &s, &c); pr = m * c; pi = m * s; }

__device__ __forceinline__ void transpose_item(const float* W, int N, bf16_t* WT, int ldt, int k0, int n0, int row_off, LAS float* scr, int lane) {
#pragma unroll 8
    for (int i = 0; i < 32; ++i) { const int kk = 2 * i + (lane >> 5); scr[kk * 33 + (lane & 31)] = W[(size_t)(k0 + kk) * N + n0 + (lane & 31)]; }
    LDS_WAIT(); asm volatile("" ::: "memory");
    const int c = lane & 7;
#pragma unroll
    for (int j = 0; j < 4; ++j) { const int n = (lane >> 3) + 8 * j; const LAS float* s = scr + (8 * c) * 33 + n;
        u32x4 o; o.x = pk2(s[0 * 33], s[1 * 33]); o.y = pk2(s[2 * 33], s[3 * 33]); o.z = pk2(s[4 * 33], s[5 * 33]); o.w = pk2(s[6 * 33], s[7 * 33]);
        *(u32x4*)(WT + (size_t)(row_off + n) * ldt + k0 + 8 * c) = o; }
    LDS_WAIT(); asm volatile("" ::: "memory");
}

__device__ __forceinline__ void transpose_item_fp8(const float* W, int N, fp8_t* WT, int ldt, int k0, int n0, int row_off, float scale, LAS float* scr, int lane) {
#pragma unroll 8
    for (int i = 0; i < 32; ++i) { const int kk = 2 * i + (lane >> 5); scr[kk * 33 + (lane & 31)] = W[(size_t)(k0 + kk) * N + n0 + (lane & 31)]; }
    LDS_WAIT(); asm volatile("" ::: "memory");
    const int c = lane & 3;
#pragma unroll
    for (int j = 0; j < 2; ++j) { const int n = (lane >> 2) + 16 * j; const LAS float* s = scr + (16 * c) * 33 + n;
        u32x4 o; o.x = pk4_fp8(s[0 * 33] * scale, s[1 * 33] * scale, s[2 * 33] * scale, s[3 * 33] * scale); o.y = pk4_fp8(s[4 * 33] * scale, s[5 * 33] * scale, s[6 * 33] * scale, s[7 * 33] * scale);
        o.z = pk4_fp8(s[8 * 33] * scale, s[9 * 33] * scale, s[10 * 33] * scale, s[11 * 33] * scale); o.w = pk4_fp8(s[12 * 33] * scale, s[13 * 33] * scale, s[14 * 33] * scale, s[15 * 33] * scale);
        *(u32x4*)(WT + (size_t)(row_off + n) * ldt + k0 + 16 * c) = o; }
    LDS_WAIT(); asm volatile("" ::: "memory");
}

__device__ __forceinline__ void phase0(const Args& a, const Ctx& F) {
    unsigned char* ws = a.ws;
    for (int unit = F.vcu; unit < 96 + 1024 + 4; unit += F.G) {
        if (unit >= 96 + 1024) {
            const int idx = (unit - 96 - 1024) * 512 + F.tid, d = idx >> 10, g = (idx >> 6) & 15, p = idx & 63;
            float lr, li, cbr, cbi; s5_param(a, d, g, p, lr, li, cbr, cbi);
            ((f32x4*)(ws + WS_PAR))[idx] = (f32x4){lr, li, cbr, cbi};
        } else if (unit < 96) {
            LAS float* S = (LAS float*)(F.lds);
            LAS float* R = (LAS float*)(F.lds + 5 * 1024 * 4);
            for (int i = F.tid; i < 5 * 1024; i += 512) { const int v = i >> 10, k = i & 1023; const float cv = v < 4 ? a.c[v * 1024 + k] : a.c_ctx[k]; S[i] = cv / (1.0f + expf(-cv)); }
            __syncthreads();
            const int n = unit * 64 + F.lane; float acc[5] = {0.f, 0.f, 0.f, 0.f, 0.f};
            const float* wp = a.w_ada + (size_t)(F.wave * 128) * 6144 + n;
#pragma unroll 8
            for (int k = 0; k < 128; ++k) { const float wv = wp[(size_t)k * 6144];
#pragma unroll
                for (int v = 0; v < 5; ++v) acc[v] += S[v * 1024 + F.wave * 128 + k] * wv; }
#pragma unroll
            for (int v = 0; v < 5; ++v) R[(F.wave * 5 + v) * 64 + F.lane] = acc[v];
            __syncthreads();
            if (F.tid < 320) { const int v = F.tid >> 6; float s = a.b_ada[n];
#pragma unroll
                for (int w = 0; w < 8; ++w) s += R[(w * 5 + v) * 64 + F.lane];
                ((float*)(ws + WS_MOD))[v * 6144 + n] = s; }
            __syncthreads();
        } else {
            const int u2 = unit - 96, d = u2 >> 9, g = (u2 >> 5) & 15, dl = 2 * (u2 & 31) + (F.tid >> 8), t = F.tid & 255, h = t >> 4, hp = t & 15;
            LAS float* PB = (LAS float*)(F.lds);
            if (t < 64) { float lr, li, cbr, cbi, pr, pi; s5_param(a, d, g, t, lr, li, cbr, cbi); cpow(lr, li, (float)dl, pr, pi);
                PB[((F.tid >> 8) * 64 + t) * 2 + 0] = pr * cbr - pi * cbi; PB[((F.tid >> 8) * 64 + t) * 2 + 1] = pr * cbi + pi * cbr; }
            __syncthreads();
            const float* cre = a.c_re + ((size_t)(d * 16 + g) * 16 + h) * 64; const float* cim = a.c_im + ((size_t)(d * 16 + g) * 16 + h) * 64;
            const float* bre = a.b_re + (size_t)(d * 16 + g) * 64 * 16 + hp; const float* bim = a.b_im + (size_t)(d * 16 + g) * 64 * 16 + hp;
            float sum = 0.f;
#pragma unroll 8
            for (int p = 0; p < 64; ++p) { const float pbr = PB[((F.tid >> 8) * 64 + p) * 2], pbi = PB[((F.tid >> 8) * 64 + p) * 2 + 1]; const float cr = cre[p], ci = cim[p];
                const float xr = cr * pbr - ci * pbi, xi = cr * pbi + ci * pbr; sum += xr * bre[p * 16] - xi * bim[p * 16]; }
            ((float*)(ws + WS_KTAB))[((size_t)((d * 16 + g) * 64 + dl)) * 256 + t] = sum;
            __syncthreads();
        }
    }
    LAS float* scr = (LAS float*)(F.lds + F.wave * 16384);
    const int gw = F.vcu * NWAVES + F.wave, NGW = F.G * NWAVES;
    constexpr int I_IN = 16 * 56, I_OUT = 16 * 32, I_GLU = 4 * 8, I_E = 16 * 88  , I_MOE = 16 * I_E;
    constexpr int NITEMS = I_IN + I_OUT + I_GLU + 3 * I_MOE;
    for (int it = gw; it < NITEMS; it += NGW) {
        int r = it;
        if (r < I_IN) { const int kb = r / 56, nb = r % 56; transpose_item(a.w_in, INC, (bf16_t*)(ws + WS_WINT), D, 64 * kb, 32 * nb, 32 * nb, scr, F.lane); continue; } r -= I_IN;
        if (r < I_OUT) { const int kb = r / 32, nb = r % 32; transpose_item(a.w_out, D, (bf16_t*)(ws + WS_WOUTT), D, 64 * kb, 32 * nb, 32 * nb, scr, F.lane); continue; } r -= I_OUT;
        if (r < I_GLU) { const int kb = r / 8, nb = r % 8; transpose_item(a.w_glu, S5W, (bf16_t*)(ws + WS_WGLUT), S5W, 64 * kb, 32 * nb, 32 * nb, scr, F.lane); continue; } r -= I_GLU;
        if (r < 2 * I_MOE) { const int s = r / I_MOE; r -= s * I_MOE; const int e = r / I_E, rr = r % I_E, kb = rr / 88, nb = rr % 88, n0 = 32 * nb;
            transpose_item_fp8((s ? a.w_up : a.w_gate) + (size_t)e * D * DFF, DFF, (fp8_t*)(ws + WS_WGU) + (size_t)e * 5632 * D, D, 64 * kb, n0, 256 * (n0 >> 7) + 128 * s + (n0 & 127), WGU_SCALE, scr, F.lane); continue; }
        r -= 2 * I_MOE;
        { const int e = r / I_E, rr = r % I_E, kb = rr / 32, nb = rr % 32;
            transpose_item_fp8(a.w_down + (size_t)e * DFF * D, D, (fp8_t*)(ws + WS_WDN) + (size_t)e * D * DFF, DFF, 64 * kb, 32 * nb, 32 * nb, WDN_SCALE, scr, F.lane); }
    }
    for (int i = (F.vcu * 512 + F.tid) * 4; i < NHEAD * 128 * 128; i += F.G * 512 * 4) { const f32x4 v = *(const f32x4*)(a.gm_ws + i); u32x2 o; o.x = pk2(v[0], v[1]); o.y = pk2(v[2], v[3]); *(u32x2*)((bf16_t*)(ws + WS_WSGM) + i) = o; }
}

__device__ __forceinline__ void modulate_finish(f32x4 (&v)[4], const float* sh, const float* sc, bf16_t* orow, int lane) {
    float s = 0.f;
#pragma unroll
    for (int j = 0; j < 4; ++j) s += (v[j].x + v[j].y) + (v[j].z + v[j].w);
    const float mean = wave_sum(s) * (1.f / D); float s2 = 0.f;
#pragma unroll
    for (int j = 0; j < 4; ++j) { v[j] = v[j] - mean; s2 += (v[j].x * v[j].x + v[j].y * v[j].y) + (v[j].z * v[j].z + v[j].w * v[j].w); }
    const float rstd = 1.f / sqrtf(wave_sum(s2) * (1.f / D) + LN_EPS);
    unsigned long long* o8 = (unsigned long long*)orow + lane;
#pragma unroll
    for (int j = 0; j < 4; ++j) { const f32x4 sv = ((const f32x4*)sh)[lane + 64 * j], cv = ((const f32x4*)sc)[lane + 64 * j]; const f32x4 o = v[j] * rstd * (cv + 1.0f) + sv;
        o8[64 * j] = (unsigned long long)pk2(o.x, o.y) | ((unsigned long long)pk2(o.z, o.w) << 32); }
}

__device__ __forceinline__ void phase1(const Args& a, const Ctx& F) {
    unsigned char* ws = a.ws; const float* mod = (const float*)(ws + WS_MOD);
    const int gw = F.vcu * NWAVES + F.wave, NGW = F.G * NWAVES;
    for (int m = gw; m < XROWS; m += 2 * NGW) {
        const int m2 = m + NGW; const bool has2 = m2 < XROWS; const int mb = has2 ? m2 : m;
        const float* srcA = m < MROWS ? a.x + (size_t)m * D : a.ctx + (size_t)(m - MROWS) * D;
        const float* srcB = mb < MROWS ? a.x + (size_t)mb * D : a.ctx + (size_t)(mb - MROWS) * D;
        f32x4 va[4], vb[4];
#pragma unroll
        for (int j = 0; j < 4; ++j) va[j] = __builtin_nontemporal_load((const f32x4*)srcA + F.lane + 64 * j);
#pragma unroll
        for (int j = 0; j < 4; ++j) vb[j] = __builtin_nontemporal_load((const f32x4*)srcB + F.lane + 64 * j);
        { const int mi = m < MROWS ? (m >> 13) : 4; modulate_finish(va, mod + mi * 6144, mod + mi * 6144 + 1024, (bf16_t*)(ws + WS_XM) + (size_t)m * D, F.lane); }
        if (has2) { const int mi = m2 < MROWS ? (m2 >> 13) : 4; modulate_finish(vb, mod + mi * 6144, mod + mi * 6144 + 1024, (bf16_t*)(ws + WS_XM) + (size_t)m2 * D, F.lane); }
    }
    const float* KT = (const float*)(ws + WS_KTAB); const f32x4* PAR = (const f32x4*)(ws + WS_PAR);
    bf16_t* BTG = (bf16_t*)(ws + WS_BTG);
    const int gt = F.vcu * 512 + F.tid, NGT = F.G * 512;
    constexpr int NA = 16 * 1024 * 128, NBI = 16 * 64 * 32, NC = 16 * 256 * 128;
    for (int it = gt; it < NA + NBI + NC; it += NGT) {
        if (it < NA) {
            const int g = it >> 17, n = (it >> 7) & 1023, k0 = (it & 127) * 8, j = n >> 4, h = n & 15, i = k0 >> 4, hp0 = k0 & 15;
            float o[8];
#pragma unroll
            for (int e = 0; e < 8; ++e) o[e] = 0.f;
            if (i <= j) { const float* kf = KT + ((size_t)((0 * 16 + g) * 64 + (j - i))) * 256 + h * 16 + hp0;
#pragma unroll
                for (int e = 0; e < 8; ++e) o[e] += kf[e]; }
            if (i >= j) { const float* kb2 = KT + ((size_t)((1 * 16 + g) * 64 + (i - j))) * 256 + h * 16 + hp0;
#pragma unroll
                for (int e = 0; e < 8; ++e) o[e] += kb2[e]; }
            if (i == j && h >= hp0 && h < hp0 + 8) { const float dv = a.s5_d[g * 16 + h];
#pragma unroll
                for (int e = 0; e < 8; ++e) o[e] += (hp0 + e == h) ? dv : 0.f; }
            u32x4 w; w.x = pk2(o[0], o[1]); w.y = pk2(o[2], o[3]); w.z = pk2(o[4], o[5]); w.w = pk2(o[6], o[7]);
            *(u32x4*)(BTG + ((size_t)(g * BT_LD + n) * BT_LD + k0)) = w;
        } else if (it < NA + NBI) {
            const int r = it - NA, g = r >> 11, j = (r >> 5) & 63, q0 = (r & 31) * 8, d = q0 >> 7, part = (q0 >> 6) & 1, p0 = q0 & 63; const float ex = d == 0 ? (float)(j + 1) : (float)(TCH - j);
            float pr[8], pi[8];
#pragma unroll
            for (int e = 0; e < 8; ++e) { const f32x4 pa = PAR[(d * 16 + g) * 64 + p0 + e]; cpow(pa.x, pa.y, ex, pr[e], pi[e]); }
            for (int h = 0; h < 16; ++h) {
                const float* cre = a.c_re + ((size_t)(d * 16 + g) * 16 + h) * 64 + p0; const float* cim = a.c_im + ((size_t)(d * 16 + g) * 16 + h) * 64 + p0;
                float o[8];
#pragma unroll
                for (int e = 0; e < 8; ++e) { const float cr = cre[e], ci = cim[e]; o[e] = part == 0 ? (cr * pr[e] - ci * pi[e]) : -(cr * pi[e] + ci * pr[e]); }
                u32x4 w; w.x = pk2(o[0], o[1]); w.y = pk2(o[2], o[3]); w.z = pk2(o[4], o[5]); w.w = pk2(o[6], o[7]);
                *(u32x4*)(BTG + ((size_t)(g * BT_LD + j * 16 + h) * BT_LD + 1024 + q0)) = w;
            }
        } else {
            const int r = it - NA - NBI, g = r >> 15, q = (r >> 7) & 255, k0 = (r & 127) * 8, d = q >> 7, part = (q >> 6) & 1, p = q & 63, i = k0 >> 4, hp0 = k0 & 15; const float ex = d == 0 ? (float)(TCH - 1 - i) : (float)i;
            const f32x4 pa = PAR[(d * 16 + g) * 64 + p]; float pr, pi; cpow(pa.x, pa.y, ex, pr, pi);
            const float wr_ = pr * pa.z - pi * pa.w, wi_ = pr * pa.w + pi * pa.z;
            const float* bre = a.b_re + ((size_t)(d * 16 + g) * 64 + p) * 16 + hp0; const float* bim = a.b_im + ((size_t)(d * 16 + g) * 64 + p) * 16 + hp0;
            float o[8];
#pragma unroll
            for (int e = 0; e < 8; ++e) { const float br = bre[e], bi = bim[e]; o[e] = part == 0 ? (wr_ * br - wi_ * bi) : (wr_ * bi + wi_ * br); }
            u32x4 w; w.x = pk2(o[0], o[1]); w.y = pk2(o[2], o[3]); w.z = pk2(o[4], o[5]); w.w = pk2(o[6], o[7]);
            *(u32x4*)(BTG + ((size_t)(g * BT_LD + 1024 + q) * BT_LD + k0)) = w;
        }
    }
}

typedef short s16x4 __attribute__((ext_vector_type(4)));
__device__ __forceinline__ s16x4 lds_tr16(const LAS unsigned char* p) { return __builtin_bit_cast(s16x4, __builtin_amdgcn_ds_read_tr16_b64_v4i16((LAS s16x4*)p)); }
__device__ __forceinline__ void gmlp_units(const Args& a, const Ctx& F, int ustart, int uend, int ustep) {
    unsigned char* ws = a.ws;
    const bf16_t* ZG = (const bf16_t*)(ws + WS_ZG);
    constexpr int RS = 272;
    LAS unsigned char* VT = F.lds;
    const int lrow = F.tid >> 2, lq = F.tid & 3;
    const int i16 = F.lane & 15, G4 = F.lane >> 4, qloc = F.wave * 16 + i16;
    if (ustart >= uend) return;
    u32x4 raw[4];
    { const int bn = ustart / NHEAD, g = ustart % NHEAD; const u32x4* src = (const u32x4*)(ZG + (size_t)(bn * 128 + lrow) * 1536 + GMW + g * 128 + lq * 32);
#pragma unroll
      for (int j = 0; j < 4; ++j) raw[j] = src[j]; }
    for (int unit = ustart; unit < uend; unit += ustep) {
        const int bn = unit / NHEAD, g = unit % NHEAD, row0 = bn * 128;
        const bf16_t* wsg = (const bf16_t*)(ws + WS_WSGM) + ((size_t)g * 128 + qloc) * 128 + 8 * G4;
        const bf16_t* up = ZG + (size_t)(row0 + qloc) * 1536 + g * 128 + 4 * G4;
        bf16x8 bfrag[4]; u32x2 uw[8];
#pragma unroll
        for (int ks = 0; ks < 4; ++ks) bfrag[ks] = *(const bf16x8*)(wsg + 32 * ks);
#pragma unroll
        for (int cb = 0; cb < 8; ++cb) uw[cb] = *(const u32x2*)(up + cb * 16);
        const float bs = a.gm_bs[g * 128 + qloc];
        {
            float v[32]; float s = 0.f;
#pragma unroll
            for (int j = 0; j < 4; ++j) { const u32x4 w = raw[j]; v[8 * j + 0] = bf_lo(w.x); v[8 * j + 1] = bf_hi(w.x); v[8 * j + 2] = bf_lo(w.y); v[8 * j + 3] = bf_hi(w.y); v[8 * j + 4] = bf_lo(w.z); v[8 * j + 5] = bf_hi(w.z); v[8 * j + 6] = bf_lo(w.w); v[8 * j + 7] = bf_hi(w.w); }
#pragma unroll
            for (int e = 0; e < 32; ++e) s += v[e];
            s += __shfl_xor(s, 1); s += __shfl_xor(s, 2);
            const float mean = s * (1.f / 128.f); float s2 = 0.f;
#pragma unroll
            for (int e = 0; e < 32; ++e) { v[e] -= mean; s2 += v[e] * v[e]; }
            s2 += __shfl_xor(s2, 1); s2 += __shfl_xor(s2, 2);
            const float rstd = 1.f / sqrtf(s2 * (1.f / 128.f) + LN_EPS);
#pragma unroll
            for (int j = 0; j < 4; ++j) { u32x4 w; w.x = pk2(v[8 * j + 0] * rstd, v[8 * j + 1] * rstd); w.y = pk2(v[8 * j + 2] * rstd, v[8 * j + 3] * rstd); w.z = pk2(v[8 * j + 4] * rstd, v[8 * j + 5] * rstd); w.w = pk2(v[8 * j + 6] * rstd, v[8 * j + 7] * rstd);
                *(LAS u32x4*)(VT + lrow * RS + lq * 64 + j * 16) = w; }
        }
        __syncthreads();
        { const int un = unit + ustep; if (un < uend) { const int bn2 = un / NHEAD, g2 = un % NHEAD; const u32x4* src = (const u32x4*)(ZG + (size_t)(bn2 * 128 + lrow) * 1536 + GMW + g2 * 128 + lq * 32);
#pragma unroll
            for (int j = 0; j < 4; ++j) raw[j] = src[j]; } }
        {
            const LAS unsigned char* tb = VT + (8 * G4 + (i16 >> 2)) * RS + (4 * (i16 & 3)) * 2;
            bf16_t* op = (bf16_t*)(ws + WS_AOUT) + (size_t)(row0 + qloc) * D + S5W + g * 128 + 4 * G4;
#pragma unroll
            for (int cb = 0; cb < 8; ++cb) {
                f32x4 acc = (f32x4){0.f, 0.f, 0.f, 0.f};
#pragma unroll
                for (int ks = 0; ks < 4; ++ks) {
                    const s16x4 lo = lds_tr16(tb + (32 * ks) * RS + cb * 32), hi = lds_tr16(tb + (32 * ks + 4) * RS + cb * 32);
                    bf16x8 af; af[0] = lo[0]; af[1] = lo[1]; af[2] = lo[2]; af[3] = lo[3]; af[4] = hi[0]; af[5] = hi[1]; af[6] = hi[2]; af[7] = hi[3];
                    acc = __builtin_amdgcn_mfma_f32_16x16x32_bf16(af, bfrag[ks], acc, 0, 0, 0);
                }
                u32x2 o; o.x = pk2(bf_lo(uw[cb].x) * (acc[0] + bs), bf_hi(uw[cb].x) * (acc[1] + bs)); o.y = pk2(bf_lo(uw[cb].y) * (acc[2] + bs), bf_hi(uw[cb].y) * (acc[3] + bs));
                *(u32x2*)(op + cb * 16) = o;
            }
        }
        __syncthreads();
    }
}

__device__ __forceinline__ void phase_scan(const Args& a, const Ctx& F) {
    unsigned char* ws = a.ws;
    LAS float* E = (LAS float*)F.lds;
    for (int unit = F.vcu; unit < NB * 16 * 2; unit += F.G) {
        const int b = unit >> 5, g = (unit >> 1) & 15, d = unit & 1, p = F.lane, seg = F.wave;
        const f32x4 pa = ((const f32x4*)(ws + WS_PAR))[(d * 16 + g) * 64 + p];
        float tr, ti; cpow(pa.x, pa.y, (float)TCH, tr, ti);
        const float* LOC = (const float*)(ws + WS_LOC) + (size_t)g * AG_ROWS * 256 + d * 128 + p;
        bf16_t* AGs = (bf16_t*)(ws + WS_AG) + (size_t)g * AG_ROWS * AG_LD + 1024 + d * 128 + p;
        float xr[16], xi[16], cr[4], ci[4];
#pragma unroll
        for (int k = 0; k < 16; ++k) { const int pos = seg * 16 + k, c = d == 0 ? pos : 127 - pos; const float* l = LOC + (size_t)(b * 128 + c) * 256; xr[k] = l[0]; xi[k] = l[64]; }
#pragma unroll
        for (int cc = 0; cc < 4; ++cc) { const int c = d == 0 ? cc : 3 - cc; const float* l = LOC + (size_t)(NCL + b * 4 + c) * 256; cr[cc] = l[0]; ci[cc] = l[64]; }
        float er = 0.f, ei = 0.f;
#pragma unroll
        for (int k = 0; k < 16; ++k) { const float nr = tr * er - ti * ei + xr[k], ni = tr * ei + ti * er + xi[k]; er = nr; ei = ni; }
        E[(seg * 64 + p) * 2] = er; E[(seg * 64 + p) * 2 + 1] = ei;
        float sr = 0.f, si = 0.f;
#pragma unroll
        for (int cc = 0; cc < 4; ++cc) { const float nr = tr * sr - ti * si + cr[cc], ni = tr * si + ti * sr + ci[cc]; sr = nr; si = ni; }
        float t16r = tr, t16i = ti;
#pragma unroll
        for (int q = 0; q < 4; ++q) { const float nr = t16r * t16r - t16i * t16i, ni = 2.f * t16r * t16i; t16r = nr; t16i = ni; }
        __syncthreads();
        for (int s2 = 0; s2 < seg; ++s2) { const float pr = E[(s2 * 64 + p) * 2], pi = E[(s2 * 64 + p) * 2 + 1]; const float nr = t16r * sr - t16i * si + pr, ni = t16r * si + t16i * sr + pi; sr = nr; si = ni; }
#pragma unroll
        for (int k = 0; k < 16; ++k) { const int pos = seg * 16 + k, c = d == 0 ? pos : 127 - pos; bf16_t* o = AGs + (size_t)(b * 128 + c) * AG_LD; o[0] = (bf16_t)f2bf(sr); o[64] = (bf16_t)f2bf(si);
            const float nr = tr * sr - ti * si + xr[k], ni = tr * si + ti * sr + xi[k]; sr = nr; si = ni; }
        __syncthreads();
    }
}

__device__ __forceinline__ void phase_ln1(const Args& a, const Ctx& F, float* xdst) {
    unsigned char* ws = a.ws; const float* mod = (const float*)(ws + WS_MOD);
    LAS f32x4* WR4 = (LAS f32x4*)F.lds;
    for (int idx = F.tid; idx < 4096; idx += 512) { const int l = idx & 63, t = idx >> 6, q = t & 3, i = (t >> 2) & 3, j = t >> 4; WR4[idx] = *(const f32x4*)(a.w_router + (size_t)(4 * l + 256 * j + i) * 16 + 4 * q); }
    __syncthreads();
    const int gw = F.vcu * NWAVES + F.wave, NGW = F.G * NWAVES;
    const int b0 = F.lane & 1, b1 = (F.lane >> 1) & 1, b2 = (F.lane >> 2) & 1, b3 = (F.lane >> 3) & 1, myexp = b3 + 2 * b2 + 4 * b1 + 8 * b0;
    f32x4 nv[4];
    if (gw < MROWS) { const f32x4* yr = (const f32x4*)(a.out + (size_t)gw * D) + F.lane;
#pragma unroll
        for (int j = 0; j < 4; ++j) nv[j] = yr[64 * j]; }
    for (int m = gw; m < MROWS; m += NGW) {
        const int b = m >> 13, t = m & (SEQ - 1);
        f32x4* yr = (f32x4*)(a.out + (size_t)m * D) + F.lane;
        f32x4 v[4]; float s = 0.f;
#pragma unroll
        for (int j = 0; j < 4; ++j) { v[j] = nv[j]; s += (v[j].x + v[j].y) + (v[j].z + v[j].w); }
        if (m + NGW < MROWS) { const f32x4* yn = (const f32x4*)(a.out + (size_t)(m + NGW) * D) + F.lane;
#pragma unroll
            for (int j = 0; j < 4; ++j) nv[j] = yn[64 * j]; }
        float mean = wave_sum(s) * (1.f / D); float s2 = 0.f;
#pragma unroll
        for (int j = 0; j < 4; ++j) { v[j] = v[j] - mean; s2 += (v[j].x * v[j].x + v[j].y * v[j].y) + (v[j].z * v[j].z + v[j].w * v[j].w); }
        float rstd = 1.f / sqrtf(wave_sum(s2) * (1.f / D) + LN_EPS);
        s = 0.f;
#pragma unroll
        for (int j = 0; j < 4; ++j) { const f32x4 lgj = ((const f32x4*)a.ln1_g)[F.lane + 64 * j], lbj = ((const f32x4*)a.ln1_b)[F.lane + 64 * j]; v[j] = v[j] * rstd * lgj + lbj; ((f32x4*)(xdst + (size_t)m * D) + F.lane)[64 * j] = v[j]; s += (v[j].x + v[j].y) + (v[j].z + v[j].w); }
        mean = wave_sum(s) * (1.f / D); s2 = 0.f;
#pragma unroll
        for (int j = 0; j < 4; ++j) { v[j] = v[j] - mean; s2 += (v[j].x * v[j].x + v[j].y * v[j].y) + (v[j].z * v[j].z + v[j].w * v[j].w); }
        rstd = 1.f / sqrtf(wave_sum(s2) * (1.f / D) + LN_EPS);
        const float* sh2 = mod + b * 6144 + 3072; const float* sc2 = mod + b * 6144 + 4096;
        unsigned* o4 = (unsigned*)((fp8_t*)(ws + WS_HF8) + (size_t)m * D) + F.lane;
        float lg16[16];
#pragma unroll
        for (int e = 0; e < 16; ++e) lg16[e] = 0.f;
#pragma unroll
        for (int j = 0; j < 4; ++j) { const f32x4 sv = ((const f32x4*)sh2)[F.lane + 64 * j], cv = ((const f32x4*)sc2)[F.lane + 64 * j]; const f32x4 h = v[j] * rstd * (cv + 1.0f) + sv;
            o4[64 * j] = pk4_fp8(h.x, h.y, h.z, h.w);
#pragma unroll
            for (int i = 0; i < 4; ++i) { const float hv = h[i];
#pragma unroll
                for (int q = 0; q < 4; ++q) { const f32x4 w = WR4[((j * 4 + i) * 4 + q) * 64 + F.lane]; lg16[4 * q + 0] += hv * w.x; lg16[4 * q + 1] += hv * w.y; lg16[4 * q + 2] += hv * w.z; lg16[4 * q + 3] += hv * w.w; }
                asm volatile("" ::: "memory"); } }
        float r8[8], r4[4], r2[2], r1;
#pragma unroll
        for (int k = 0; k < 8; ++k) { const float snd = b0 ? lg16[k] : lg16[k + 8], kp = b0 ? lg16[k + 8] : lg16[k]; r8[k] = kp + __shfl_xor(snd, 1); }
#pragma unroll
        for (int k = 0; k < 4; ++k) { const float snd = b1 ? r8[k] : r8[k + 4], kp = b1 ? r8[k + 4] : r8[k]; r4[k] = kp + __shfl_xor(snd, 2); }
#pragma unroll
        for (int k = 0; k < 2; ++k) { const float snd = b2 ? r4[k] : r4[k + 2], kp = b2 ? r4[k + 2] : r4[k]; r2[k] = kp + __shfl_xor(snd, 4); }
        { const float snd = b3 ? r2[0] : r2[1], kp = b3 ? r2[1] : r2[0]; r1 = kp + __shfl_xor(snd, 8); }
        r1 += __shfl_xor(r1, 16); r1 += __shfl_xor(r1, 32);
        float mx = r1;
#pragma unroll
        for (int o = 1; o < 16; o <<= 1) mx = fmaxf(mx, __shfl_xor(mx, o));
        const float ex = expf(r1 - mx); float den = ex;
#pragma unroll
        for (int o = 1; o < 16; o <<= 1) den += __shfl_xor(den, o);
        if (F.lane < 16) ((float*)(ws + WS_AFF))[((size_t)(b * 16 + myexp)) * SEQ + t] = ex / den;
    }
}

__device__ __forceinline__ void topk_unit(const Args& a, const Ctx& F, int be) {
    unsigned char* ws = a.ws;
    LAS unsigned* hist = (LAS unsigned*)F.lds;
    LAS unsigned* bc = hist + 256;
    LAS unsigned* wtot = hist + 272;
    const int b = be >> 4, e = be & 15;
    const float* aff = (const float*)(ws + WS_AFF) + (size_t)be * SEQ + F.tid * 16;
    unsigned key[16];
#pragma unroll
    for (int j = 0; j < 4; ++j) { const u32x4 w = ((const u32x4*)aff)[j]; key[4 * j] = w.x; key[4 * j + 1] = w.y; key[4 * j + 2] = w.z; key[4 * j + 3] = w.w; }
    unsigned prefix = 0u, mask = 0u, kk = CAP;
    for (int pass = 0; pass < 4; ++pass) {
        const int shift = 24 - 8 * pass;
        if (F.tid < 256) hist[F.tid] = 0u;
        __syncthreads();
#pragma unroll
        for (int i = 0; i < 16; ++i) if ((key[i] & mask) == prefix) __hip_atomic_fetch_add(&hist[(key[i] >> shift) & 255u], 1u, __ATOMIC_RELAXED, __HIP_MEMORY_SCOPE_WORKGROUP);
        __syncthreads();
        if (F.wave == 0) {
            const unsigned c0 = hist[4 * F.lane], c1 = hist[4 * F.lane + 1], c2 = hist[4 * F.lane + 2], c3 = hist[4 * F.lane + 3];
            unsigned suf = c0 + c1 + c2 + c3;
#pragma unroll
            for (int o = 1; o < 64; o <<= 1) { const unsigned t = __shfl_down(suf, o); suf += (F.lane + o < 64) ? t : 0u; }
            const unsigned above = suf - (c0 + c1 + c2 + c3);
            if (suf >= kk && above < kk) {
                unsigned cum = above, bin, rem;
                if (cum + c3 >= kk) { bin = 3; rem = kk - cum; } else { cum += c3; if (cum + c2 >= kk) { bin = 2; rem = kk - cum; } else { cum += c2; if (cum + c1 >= kk) { bin = 1; rem = kk - cum; } else { cum += c1; bin = 0; rem = kk - cum; } } }
                bc[0] = 4 * F.lane + bin; bc[1] = rem;
            }
        }
        __syncthreads();
        prefix |= bc[0] << shift; mask |= 0xFFu << shift; kk = bc[1];
        __syncthreads();
    }
    unsigned ngt = 0, neq = 0;
#pragma unroll
    for (int i = 0; i < 16; ++i) { ngt += key[i] > prefix ? 1u : 0u; neq += key[i] == prefix ? 1u : 0u; }
    unsigned sg = ngt, se = neq;
#pragma unroll
    for (int o = 1; o < 64; o <<= 1) { const unsigned tg = __shfl_up(sg, o), te = __shfl_up(se, o); if (F.lane >= o) { sg += tg; se += te; } }
    if (F.lane == 63) { wtot[F.wave * 2] = sg; wtot[F.wave * 2 + 1] = se; }
    __syncthreads();
    unsigned gbase = sg - ngt, ebase = se - neq;
    for (int w = 0; w < F.wave; ++w) { gbase += wtot[w * 2]; ebase += wtot[w * 2 + 1]; }
    int* SEL = (int*)(ws + WS_SEL) + be * CAP; float* GATE = (float*)(ws + WS_GATE) + be * CAP; int* INV = (int*)(ws + WS_INV);
#pragma unroll
    for (int i = 0; i < 16; ++i) {
        const int t = F.tid * 16 + i; int slot = -1;
        if (key[i] > prefix) { slot = (int)(gbase + (ebase < kk ? ebase : kk)); ++gbase; }
        else if (key[i] == prefix) { if (ebase < kk) slot = (int)(gbase + ebase); ++ebase; }
        if (slot >= 0) { SEL[slot] = b * SEQ + t; GATE[slot] = __uint_as_float(key[i]); }
        INV[(size_t)(b * SEQ + t) * NE + e] = slot;
    }
    __syncthreads();
}

__device__ __forceinline__ void final_accum(const bf16_t* YEXP, int b, int slotv, unsigned bal, f32x4 (&mo)[4], int lane) {
    while (bal) {
        int ee[4]; bool on[4];
#pragma unroll
        for (int q = 0; q < 4; ++q) { on[q] = bal != 0u; ee[q] = on[q] ? __builtin_ctz(bal) : ee[0]; bal = on[q] ? (bal & (bal - 1u)) : bal; }
        unsigned long long w[4][4];
#pragma unroll
        for (int q = 0; q < 4; ++q) { const int slot = __builtin_amdgcn_readlane(slotv, ee[q]); const unsigned long long* yr = (const unsigned long long*)(YEXP + ((size_t)((b * 16 + ee[q]) * CAP + slot)) * D) + lane;
#pragma unroll
            for (int j = 0; j < 4; ++j) w[q][j] = yr[64 * j]; }
#pragma unroll
        for (int q = 0; q < 4; ++q) if (on[q]) {
#pragma unroll
            for (int j = 0; j < 4; ++j) { const unsigned lo = (unsigned)w[q][j], hi = (unsigned)(w[q][j] >> 32); mo[j].x += bf_lo(lo); mo[j].y += bf_hi(lo); mo[j].z += bf_lo(hi); mo[j].w += bf_hi(hi); } }
    }
}
__device__ __forceinline__ void final_finish(const Args& a, const float* g2, const f32x4 (&xv)[4], const f32x4 (&mo)[4], float* orow, int lane) {
    f32x4 v[4]; float s = 0.f;
#pragma unroll
    for (int j = 0; j < 4; ++j) { const f32x4 gv = ((const f32x4*)g2)[lane + 64 * j]; v[j] = xv[j] * ALPHA + gv * mo[j]; s += (v[j].x + v[j].y) + (v[j].z + v[j].w); }
    const float mean = wave_sum(s) * (1.f / D); float s2 = 0.f;
#pragma unroll
    for (int j = 0; j < 4; ++j) { v[j] = v[j] - mean; s2 += (v[j].x * v[j].x + v[j].y * v[j].y) + (v[j].z * v[j].z + v[j].w * v[j].w); }
    const float rstd = 1.f / sqrtf(wave_sum(s2) * (1.f / D) + LN_EPS);
#pragma unroll
    for (int j = 0; j < 4; ++j) { const f32x4 gv = ((const f32x4*)a.ln2_g)[lane + 64 * j], bv = ((const f32x4*)a.ln2_b)[lane + 64 * j]; ((f32x4*)orow + lane)[64 * j] = v[j] * rstd * gv + bv; }
}
__device__ __forceinline__ void phase_final(const Args& a, const Ctx& F, float* xdst) {
    unsigned char* ws = a.ws; const float* mod = (const float*)(ws + WS_MOD);
    const int gw = F.vcu * NWAVES + F.wave, NGW = F.G * NWAVES;
    const bf16_t* YEXP = (const bf16_t*)(ws + WS_YEXP); const int* INV = (const int*)(ws + WS_INV);
    for (int m = gw; m < MROWS; m += 2 * NGW) {
        const int m2 = m + NGW; const bool has2 = m2 < MROWS; const int mb = has2 ? m2 : m;
        const int slotA = INV[(size_t)m * NE + (F.lane & 15)], slotB = INV[(size_t)mb * NE + (F.lane & 15)];
        f32x4 xa[4], xb[4];
#pragma unroll
        for (int j = 0; j < 4; ++j) xa[j] = ((const f32x4*)(a.out + (size_t)m * D) + F.lane)[64 * j];
#pragma unroll
        for (int j = 0; j < 4; ++j) xb[j] = ((const f32x4*)(a.out + (size_t)mb * D) + F.lane)[64 * j];
        f32x4 moa[4], mob[4];
#pragma unroll
        for (int j = 0; j < 4; ++j) { moa[j] = (f32x4){0.f, 0.f, 0.f, 0.f}; mob[j] = (f32x4){0.f, 0.f, 0.f, 0.f}; }
        const unsigned balA = (unsigned)__ballot(slotA >= 0) & 0xFFFFu, balB = (unsigned)__ballot(slotB >= 0) & 0xFFFFu;
        final_accum(YEXP, m >> 13, slotA, balA, moa, F.lane);
        final_accum(YEXP, mb >> 13, slotB, balB, mob, F.lane);
        final_finish(a, mod + (m >> 13) * 6144 + 5120, xa, moa, xdst + (size_t)m * D, F.lane);
        if (has2) final_finish(a, mod + (m2 >> 13) * 6144 + 5120, xb, mob, xdst + (size_t)m2 * D, F.lane);
    }
}

__global__ void __launch_bounds__(NWAVES * 64, 2) dit_fwd(Args args) {
    extern __shared__ __attribute__((aligned(16))) unsigned char lds[];
    Ctx F;
    F.lds = (LAS unsigned char*)lds;
    F.tid = threadIdx.x; F.lane = F.tid & 63; F.wave = __builtin_amdgcn_readfirstlane(F.tid >> 6);
    F.G = gridDim.x; { const int bx = blockIdx.x; F.vcu = (F.G % 8 == 0) ? (bx % 8) * (F.G / 8) + bx / 8 : bx; }
    volatile LAS unsigned* MISC = (volatile LAS unsigned*)(F.lds + MISC_OFF);
    unsigned char* ws = args.ws;
    gu32* ctl = (gu32*)(ws + WS_CTL);
    for (int u = F.tid; u < (LDS_BYTES - LDSCTL_OFF) / 4; u += NWAVES * 64) ((LAS unsigned*)(F.lds + LDSCTL_OFF))[u] = 0u;
    __syncthreads();
    XcdBarrier bar; bar.bar = (unsigned*)(ctl + CW_BAR); bar.x = 0; bar.st = nullptr;
    if (N_LAUNCHES == 1) bar = xcd_barrier_post((unsigned*)(ctl + CW_BAR), MISC + 8);
    const int lo = args.ph_lo, hi = args.ph_hi;
#ifndef PH_MASK
#define PH_MASK 0xFFFFF
#endif
#define IN(k) (((PH_MASK >> (k)) & 1) && lo <= (k) && (k) < hi)
#ifndef REP_MASK
#define REP_MASK 0
#endif
#ifndef BAR_REPS
#define BAR_REPS 1
#endif
#define REPS(k) (((REP_MASK >> (k)) & 1) ? 2 : 1)
#define SEAM(k) do { if (IN(k) && IN((k) + 1)) { for (int _b = 0; _b < BAR_REPS; ++_b) xcd_barrier(bar); } } while (0)
#define RSEAM(k, rep) do { if (N_LAUNCHES == 1 && (rep) + 1 < REPS(k)) xcd_barrier(bar); } while (0)
    const int G = F.G, cb = (int)blockIdx.x;

#define PH_BODY_0 phase0(args, F);
    if (IN(0)) { { PH_BODY_0 } if (REPS(0) == 2) { RSEAM(0, 0); { PH_BODY_0 } } } SEAM(0);
#define PH_BODY_1 phase1(args, F);
    if (IN(1)) { { PH_BODY_1 } if (REPS(1) == 2) { RSEAM(1, 0); { PH_BODY_1 } } } SEAM(1);
#define PH_BODY_2 PInProj p{(const bf16_t*)(ws + WS_XM), (const bf16_t*)(ws + WS_WINT), (bf16_t*)(ws + WS_AG), (bf16_t*)(ws + WS_ZG), G, cb}; pg8::gemm_phase(F.lds + RING_OFF, p);
    if (IN(2)) { { PH_BODY_2 } if (REPS(2) == 2) { RSEAM(2, 0); { PH_BODY_2 } } } SEAM(2);
#define PH_BODY_3 \
        { PLoc p{(const bf16_t*)(ws + WS_AG), (const bf16_t*)(ws + WS_BTG), (float*)(ws + WS_LOC), G, cb}; pg8::gemm_phase(F.lds + RING_OFF, p); } \
        __syncthreads(); \
         \
        { const int nun = MROWS / 128 * NHEAD; const int heavy = 48 < G ? 48 : 0; const int light = G - heavy; \
          if (cb >= heavy) gmlp_units(args, F, cb - heavy, nun - heavy, light); \
          else gmlp_units(args, F, nun - heavy + cb, nun - heavy + cb + 1, 1); } \

    if (IN(3)) { { PH_BODY_3 } if (REPS(3) == 2) { RSEAM(3, 0); { PH_BODY_3 } } } SEAM(3);
#define PH_BODY_4 phase_scan(args, F);
    if (IN(4)) { { PH_BODY_4 } if (REPS(4) == 2) { RSEAM(4, 0); { PH_BODY_4 } } } SEAM(4);
#define PH_BODY_5 PS5Main p{(const bf16_t*)(ws + WS_AG), (const bf16_t*)(ws + WS_BTG), (bf16_t*)(ws + WS_GY), G, cb}; pg8::gemm_phase(F.lds + RING_OFF, p);
    if (IN(5)) { { PH_BODY_5 } if (REPS(5) == 2) { RSEAM(5, 0); { PH_BODY_5 } } } SEAM(5);
#define PH_BODY_6 PGlu p{(const bf16_t*)(ws + WS_GY), (const bf16_t*)(ws + WS_WGLUT), args.b_glu, (bf16_t*)(ws + WS_AOUT), G, cb}; pg8::gemm_phase(F.lds + RING_OFF, p);
    if (IN(6)) { { PH_BODY_6 } if (REPS(6) == 2) { RSEAM(6, 0); { PH_BODY_6 } } } SEAM(6);
#define PH_BODY_7 POutProj p{(const bf16_t*)(ws + WS_AOUT), (const bf16_t*)(ws + WS_WOUTT), args.x, (const float*)(ws + WS_MOD), args.out, G, cb}; pg8::gemm_phase(F.lds + RING_OFF, p);
    if (IN(7)) { { PH_BODY_7 } if (REPS(7) == 2) { RSEAM(7, 0); { PH_BODY_7 } } } SEAM(7);
#define PH_BODY_8 phase_ln1(args, F, args.out);
    if (IN(8)) { if (REPS(8) == 2) { phase_ln1(args, F, (float*)(ws + WS_HID)); RSEAM(8, 0); } { PH_BODY_8 } } SEAM(8);
#define PH_BODY_9 for (int u = F.vcu; u < NB * NE; u += F.G) topk_unit(args, F, u);
    if (IN(9)) { { PH_BODY_9 } if (REPS(9) == 2) { RSEAM(9, 0); { PH_BODY_9 } } } SEAM(9);
#define PH_BODY_10 PGateUp p{(const fp8_t*)(ws + WS_HF8), (const fp8_t*)(ws + WS_WGU), (const int*)(ws + WS_SEL), (fp8_t*)(ws + WS_HID), G, cb}; pg8::gemm_phase(F.lds + RING_OFF, p);
    if (IN(10)) { { PH_BODY_10 } if (REPS(10) == 2) { RSEAM(10, 0); { PH_BODY_10 } } } SEAM(10);
#define PH_BODY_11 PDown p{(const fp8_t*)(ws + WS_HID), (const fp8_t*)(ws + WS_WDN), (const float*)(ws + WS_GATE), (bf16_t*)(ws + WS_YEXP), G, cb}; pg8::gemm_phase(F.lds + RING_OFF, p);
    if (IN(11)) { { PH_BODY_11 } if (REPS(11) == 2) { RSEAM(11, 0); { PH_BODY_11 } } } SEAM(11);
    if (IN(12)) { if (REPS(12) == 2) { phase_final(args, F, (float*)(ws + WS_HID)); RSEAM(12, 0); } phase_final(args, F, args.out); }
#undef IN
#undef SEAM
}

extern "C" void kernel_launch(void* const* d_in, const int* in_sizes, int n_in, void* d_out, int out_size, void* d_ws, size_t ws_size, hipStream_t stream) {
    static int grid = 0;
    if (grid == 0) {
        if (n_in != 28 || in_sizes[0] != MROWS * D || out_size != MROWS * D || ws_size < WS_END) {
            fprintf(stderr, "kernel_launch: built for 28 inputs, x/out of %d floats, >= %zu bytes of workspace; got n_in %d, in0 %d, out %d, ws %zu; nothing launched\n", MROWS * D, (size_t)WS_END, n_in, n_in > 0 ? in_sizes[0] : -1, out_size, ws_size);
            grid = -1; return; }
        int dev = 0, cus = 0, per_cu = 0;
        if (hipGetDevice(&dev) != hipSuccess || hipDeviceGetAttribute(&cus, hipDeviceAttributeMultiprocessorCount, dev) != hipSuccess) { fprintf(stderr, "kernel_launch: device query failed\n"); grid = -1; return; }
        if (hipFuncSetAttribute((const void*)dit_fwd, hipFuncAttributeMaxDynamicSharedMemorySize, LDS_BYTES) != hipSuccess) { fprintf(stderr, "kernel_launch: hipFuncSetAttribute failed\n"); grid = -1; return; }
        if (hipOccupancyMaxActiveBlocksPerMultiprocessor(&per_cu, (const void*)dit_fwd, NWAVES * 64, LDS_BYTES) != hipSuccess || per_cu < 1)
            fprintf(stderr, "kernel_launch: note: occupancy query reports %d workgroups per CU\n", per_cu);
        (void)hipGetLastError();
        grid = cus;
    }
    if (grid < 0) return;
    if (hipMemsetAsync((char*)d_ws + WS_CTL, 0, CTL_ZERO_BYTES, stream) != hipSuccess) { fprintf(stderr, "kernel_launch: hipMemsetAsync failed\n"); return; }
    Args a{};
    const float** ap = (const float**)&a;
    for (int i = 0; i < 28; ++i) ap[i] = (const float*)d_in[i];
    a.out = (float*)d_out; a.ws = (unsigned char*)d_ws;
    for (int li = 0; li < N_LAUNCHES; ++li) {
        a.ph_lo = (N_LAUNCHES == 1) ? 0 : li; a.ph_hi = (N_LAUNCHES == 1) ? NPH : li + 1;
        hipLaunchKernelGGL(dit_fwd, dim3(grid), dim3(NWAVES * 64), LDS_BYTES, stream, a);
        const hipError_t le = hipPeekAtLastError();
        if (le != hipSuccess) { fprintf(stderr, "kernel_launch: launch %d failed: %s\n", li, hipGetErrorName(le)); break; }
    }
}
```
